# Optimizing an MI355X kernel written in HIP

```python
import math
import jax, jax.numpy as jnp
from jax import lax
import numpy as np

D_MODEL = 1024
BATCH = 2
SEQ = 16384
DEPTH = 2
DEC_BATCH = 16
DEC_SEQ = 16
PAST_LEN = 2048

CHUNK = 64
H_A = 8
DA = 64
DVA = 2 * DA
H_B = 8
DB = 64
BAND_CHUNKS = 8
BAND_PAST = BAND_CHUNKS * CHUNK
BAND = BAND_PAST + CHUNK
REL_CLIP = 128
D_FF = 4 * D_MODEL
Q_BLOCK = 128
EPS = 1e-6
NEG_INF = -1e30
W_A_QK = H_A * 2 * DA
W_A_V = H_A * DVA
W_B = H_B * DB
IN_COLS = 2 * W_A_QK + W_A_V + 3 * W_B
SPLITS = (W_A_QK, 2 * W_A_QK, 2 * W_A_QK + W_A_V, 2 * W_A_QK + W_A_V + W_B, 2 * W_A_QK + W_A_V + 2 * W_B)

kernel_name = 'hybrid_diffattn_chunkband_stream_step'


def rms(x, g):
    xf = x.astype(jnp.float32)
    return xf * lax.rsqrt(jnp.mean(xf * xf, axis=-1, keepdims=True) + EPS) * g.astype(jnp.float32)


def alibi_slopes():
    return jnp.exp2(-8.0 * jnp.arange(1, H_A + 1, dtype=jnp.float32) / H_A)


def project(h, w_in, qn_a, kn_a, qn_b, kn_b):
    b, t = h.shape[:2]
    z = h @ w_in
    qa, ka, va, qb, kb, vb = jnp.split(z, SPLITS, axis=-1)
    qa = rms(qa.reshape(b, t, H_A, 2, DA), qn_a)
    ka = rms(ka.reshape(b, t, H_A, 2, DA), kn_a).reshape(b, t, H_A, 2 * DA)
    va = va.reshape(b, t, H_A, DVA)
    qb = rms(qb.reshape(b, t, H_B, DB), qn_b)
    kb = rms(kb.reshape(b, t, H_B, DB), kn_b)
    vb = vb.reshape(b, t, H_B, DB)
    return qa, ka, va, qb, kb, vb


def diff_attention(qa, k, v, q_pos, k_pos, lam):
    q1 = qa[..., 0, :]
    q2 = qa[..., 1, :]
    k1 = k[..., :DA]
    k2 = k[..., DA:]
    visible = (k_pos[None, :] // CHUNK) <= (q_pos[:, None] // CHUNK)
    dist = jnp.abs(q_pos[:, None] - k_pos[None, :]).astype(jnp.float32)
    bias = jnp.where(visible[None], -alibi_slopes()[:, None, None] * dist[None], NEG_INF)
    scale = DA ** -0.5
    p1 = jax.nn.softmax(jnp.einsum('bqhd,bkhd->bhqk', q1, k1) * scale + bias, axis=-1)
    p2 = jax.nn.softmax(jnp.einsum('bqhd,bkhd->bhqk', q2, k2) * scale + bias, axis=-1)
    return jnp.einsum('bhqk,bkhe->bqhe', p1 - lam * p2, v)


def band_attention(q, k, v, q_pos, k_pos, rel_bias):
    dchunk = q_pos[:, :, None] // CHUNK - k_pos[:, None, :] // CHUNK
    visible = (k_pos[:, None, :] >= 0) & (dchunk >= 0) & (dchunk <= BAND_CHUNKS)
    rel = jnp.clip(q_pos[:, :, None] - k_pos[:, None, :], -REL_CLIP, REL_CLIP) + REL_CLIP
    bias = jnp.where(visible[None], rel_bias.astype(jnp.float32)[:, rel], NEG_INF)
    s = jnp.einsum('bnqhd,bnkhd->bhnqk', q, k) * (DB ** -0.5) + bias
    p = jax.nn.softmax(s, axis=-1)
    return jnp.einsum('bhnqk,bnkhd->bnqhd', p, v)


def merge_and_ffn(x, h, oa, ob, lam_init, subln_g, w_br_a, w_br_b, w_gate, w_out, norm2_g, w_ff1, w_ff2):
    b, t = x.shape[:2]
    ya = (rms(oa, subln_g) * (1.0 - lam_init)).reshape(b, t, W_A_V) @ w_br_a
    yb = ob.reshape(b, t, W_B) @ w_br_b
    ga, gb = jnp.split(jax.nn.sigmoid(h @ w_gate), 2, axis=-1)
    x = x + (ga * ya + gb * yb) @ w_out
    u = jnp.maximum(rms(x, norm2_g) @ w_ff1, 0.0)
    return x + (u * u) @ w_ff2


def setup_inputs(seed: int = 0) -> dict:
    key = jax.random.key(seed)
    ks = jax.random.split(key, 25)
    f32 = jnp.float32
    nrm = lambda k, shape, scale: jax.random.normal(k, shape, f32) * scale
    gain = lambda k, shape: 1.0 + 0.02 * jax.random.normal(k, shape, f32)
    b_keep = min(BAND_PAST, PAST_LEN)
    return {
        'x_prompt': nrm(ks[0], (BATCH, SEQ, D_MODEL), 1.0),
        'x_sample': nrm(ks[1], (DEC_BATCH, DEC_SEQ, D_MODEL), 1.0),
        'cache_a_k': nrm(ks[2], (DEPTH, DEC_BATCH, PAST_LEN, H_A, 2 * DA), 1.0),
        'cache_a_v': nrm(ks[3], (DEPTH, DEC_BATCH, PAST_LEN, H_A, DVA), 1.0),
        'cache_b_k': nrm(ks[4], (DEPTH, DEC_BATCH, b_keep, H_B, DB), 1.0),
        'cache_b_v': nrm(ks[5], (DEPTH, DEC_BATCH, b_keep, H_B, DB), 1.0),
        'norm1_g': gain(ks[6], (DEPTH, D_MODEL)),
        'w_in': nrm(ks[7], (DEPTH, D_MODEL, IN_COLS), D_MODEL ** -0.5),
        'qn_a_g': gain(ks[8], (DEPTH, DA)),
        'kn_a_g': gain(ks[9], (DEPTH, DA)),
        'qn_b_g': gain(ks[10], (DEPTH, DB)),
        'kn_b_g': gain(ks[11], (DEPTH, DB)),
        'lam_q1': nrm(ks[12], (DEPTH, DA), 0.1),
        'lam_k1': nrm(ks[13], (DEPTH, DA), 0.1),
        'lam_q2': nrm(ks[14], (DEPTH, DA), 0.1),
        'lam_k2': nrm(ks[15], (DEPTH, DA), 0.1),
        'subln_a_g': gain(ks[16], (DEPTH, DVA)),
        'rel_bias_b': nrm(ks[17], (DEPTH, H_B, 2 * REL_CLIP + 1), 0.5),
        'w_br_a': nrm(ks[18], (DEPTH, W_A_V, D_MODEL), W_A_V ** -0.5),
        'w_br_b': nrm(ks[19], (DEPTH, W_B, D_MODEL), W_B ** -0.5),
        'w_gate': nrm(ks[20], (DEPTH, D_MODEL, 2 * D_MODEL), D_MODEL ** -0.5),
        'w_out': nrm(ks[21], (DEPTH, D_MODEL, D_MODEL), D_MODEL ** -0.5),
        'norm2_g': gain(ks[22], (DEPTH, D_MODEL)),
        'w_ff1': nrm(ks[23], (DEPTH, D_MODEL, D_FF), D_MODEL ** -0.5),
        'w_ff2': nrm(ks[24], (DEPTH, D_FF, D_MODEL), D_FF ** -0.5),
    }


def reference(x_prompt, x_sample, cache_a_k, cache_a_v, cache_b_k, cache_b_v,
              norm1_g, w_in, qn_a_g, kn_a_g, qn_b_g, kn_b_g,
              lam_q1, lam_k1, lam_q2, lam_k2, subln_a_g, rel_bias_b,
              w_br_a, w_br_b, w_gate, w_out, norm2_g, w_ff1, w_ff2):
    f32 = jnp.float32
    bp, s = x_prompt.shape[:2]
    t = x_sample.shape[1]
    p_len = cache_a_k.shape[2]
    b_keep = cache_b_k.shape[2]
    nb = s // Q_BLOCK
    nc = s // CHUNK
    keep_p = min(BAND_PAST, s)

    pos_p = jnp.arange(s)
    pos_blocks = pos_p.reshape(nb, Q_BLOCK)
    band_idx = jnp.arange(nc)[:, None] * CHUNK + jnp.arange(BAND)[None, :]
    band_kpos = band_idx - BAND_PAST
    pos_chunks = pos_p.reshape(nc, CHUNK)
    q_pos_s = p_len + jnp.arange(t)
    k_pos_a_s = jnp.arange(p_len + t)
    k_pos_b_s = jnp.arange(p_len - b_keep, p_len + t)
    pad_rows = lambda r: jnp.pad(r, ((0, 0), (BAND_PAST, 0), (0, 0), (0, 0)))

    xp = x_prompt.astype(f32)
    xs = x_sample.astype(f32)
    ak_p, av_p, bk_p, bv_p = [], [], [], []
    ak_s, av_s, bk_s, bv_s = [], [], [], []
    for l in range(DEPTH):
        lam_init = 0.8 - 0.6 * math.exp(-0.3 * l)
        lam = (jnp.exp(jnp.sum(lam_q1[l].astype(f32) * lam_k1[l].astype(f32)))
               - jnp.exp(jnp.sum(lam_q2[l].astype(f32) * lam_k2[l].astype(f32))) + lam_init)
        w_in_l = w_in[l].astype(f32)
        tail = functools_partial_args = (lam_init, subln_a_g[l], w_br_a[l].astype(f32), w_br_b[l].astype(f32),
                                         w_gate[l].astype(f32), w_out[l].astype(f32), norm2_g[l],
                                         w_ff1[l].astype(f32), w_ff2[l].astype(f32))

        hp = rms(xp, norm1_g[l])
        qa, ka, va, qb, kb, vb = project(hp, w_in_l, qn_a_g[l], kn_a_g[l], qn_b_g[l], kn_b_g[l])
        qa_blocks = qa.reshape(bp, nb, Q_BLOCK, H_A, 2, DA).swapaxes(0, 1)
        oa = lax.map(lambda a: diff_attention(a[0], ka, va, a[1], pos_p, lam), (qa_blocks, pos_blocks))
        oa = oa.swapaxes(0, 1).reshape(bp, s, H_A, DVA)
        ob = band_attention(qb.reshape(bp, nc, CHUNK, H_B, DB), pad_rows(kb)[:, band_idx],
                            pad_rows(vb)[:, band_idx], pos_chunks, band_kpos, rel_bias_b[l])
        ob = ob.reshape(bp, s, H_B, DB)
        xp = merge_and_ffn(xp, hp, oa, ob, *tail)
        ak_p.append(ka)
        av_p.append(va)
        bk_p.append(kb[:, s - keep_p:])
        bv_p.append(vb[:, s - keep_p:])

        hs = rms(xs, norm1_g[l])
        qa2, ka2, va2, qb2, kb2, vb2 = project(hs, w_in_l, qn_a_g[l], kn_a_g[l], qn_b_g[l], kn_b_g[l])
        ka_all = jnp.concatenate([cache_a_k[l].astype(f32), ka2], axis=1)
        va_all = jnp.concatenate([cache_a_v[l].astype(f32), va2], axis=1)
        oa2 = diff_attention(qa2, ka_all, va_all, q_pos_s, k_pos_a_s, lam)
        kb_all = jnp.concatenate([cache_b_k[l].astype(f32), kb2], axis=1)
        vb_all = jnp.concatenate([cache_b_v[l].astype(f32), vb2], axis=1)
        ob2 = band_attention(qb2[:, None], kb_all[:, None], vb_all[:, None],
                             q_pos_s[None], k_pos_b_s[None], rel_bias_b[l])[:, 0]
        xs = merge_and_ffn(xs, hs, oa2, ob2, *tail)
        ak_s.append(ka2)
        av_s.append(va2)
        bk_s.append(kb2)
        bv_s.append(vb2)

    cdt = cache_a_k.dtype
    y_prompt = xp.astype(x_prompt.dtype)
    y_sample = xs.astype(x_sample.dtype)
    return (y_prompt, y_sample,
            jnp.stack(ak_p).astype(cdt), jnp.stack(av_p).astype(cdt),
            jnp.stack(bk_p).astype(cdt), jnp.stack(bv_p).astype(cdt),
            jnp.stack(ak_s).astype(cdt), jnp.stack(av_s).astype(cdt),
            jnp.stack(bk_s).astype(cdt), jnp.stack(bv_s).astype(cdt))
```

```cpp
#include <hip/hip_runtime.h>
#include <hip/hip_cooperative_groups.h>
#include <cstdio>
#include <cstdint>
namespace cg = cooperative_groups;

#define LAS __attribute__((address_space(3)))
typedef unsigned short bf16_t;
typedef short bf16x8 __attribute__((ext_vector_type(8)));
typedef short s16x4 __attribute__((ext_vector_type(4)));
typedef float f32x4 __attribute__((ext_vector_type(4)));
typedef float f32x16 __attribute__((ext_vector_type(16)));
typedef unsigned u32x4 __attribute__((ext_vector_type(4)));
typedef unsigned u32x2 __attribute__((ext_vector_type(2)));

constexpr int DM = 1024, SEQ = 16384, MP = 2 * SEQ, MS = 256, MT = MP + MS;
constexpr int NIN = 4608, NG1 = 6656, DFF = 4096;
constexpr int SA_LEN = 2112, SB_LEN = 576;
constexpr int KA_ROWS = MP + 16 * SA_LEN, KB_ROWS = MP + 16 * SB_LEN;
constexpr float EPS = 1e-6f, LOG2E = 1.4426950408889634f, C2 = 0.125f * LOG2E;
constexpr size_t O_Y = 0, O_AK_P = 33816576, O_AV_P = 100925440, O_BK_P = 168034304, O_BV_P = 169082880,
                 O_AK_S = 170131456, O_AV_S = 170655744, O_BK_S = 171180032, O_BV_S = 171442176;
constexpr size_t MiB = 1u << 20;
constexpr size_t WL_W1 = 0, WL_BRA = 13631488, WL_BRB = WL_BRA + 2097152, WL_OUT = WL_BRB + 1048576, WL_FF1 = WL_OUT + 2097152, WL_FF2 = WL_FF1 + 8388608, WL_SIZE = 34 * MiB;
constexpr size_t WS_W = 0, WS_XN = 68 * MiB, WS_X1 = WS_XN + 65 * MiB, WS_QA = WS_X1 + 129 * MiB, WS_QB = WS_QA + 65 * MiB, WS_KA = WS_QB + 33 * MiB,
                 WS_VA = WS_KA + 130 * MiB, WS_KB = WS_VA + 130 * MiB, WS_VB = WS_KB + 41 * MiB, WS_GATE = WS_VB + 41 * MiB, WS_END = WS_GATE + 129 * MiB;
constexpr size_t WS_CTR = WS_END;
constexpr size_t WS_U = WS_KA;
static_assert((size_t)KA_ROWS * 1024 * 2 <= 130 * MiB && (size_t)MT * 4096 * 2 <= 260 * MiB && (size_t)KB_ROWS * 512 * 2 <= 41 * MiB && WS_END <= 1024 * MiB, "ws map");

constexpr int GEMM_LDS = 131072, LDS_BYTES = 147456;

__device__ __forceinline__ unsigned cvt_pk_bf16(float lo, float hi) { unsigned r; asm volatile("v_cvt_pk_bf16_f32 %0, %1, %2" : "=v"(r) : "v"(lo), "v"(hi)); return r; }
__device__ __forceinline__ unsigned f2bf(float f) { unsigned u = __builtin_bit_cast(unsigned, f); return (u + 0x7fffu + ((u >> 16) & 1u)) >> 16; }
__device__ __forceinline__ unsigned pk2(float lo, float hi) { return f2bf(lo) | (f2bf(hi) << 16); }
__device__ __forceinline__ float bf2f(unsigned short b) { return __builtin_bit_cast(float, (unsigned)b << 16); }


__device__ __forceinline__ void swap32(float& a, float& b) { asm volatile("s_nop 1\n\tv_permlane32_swap_b32 %0, %1\n\ts_nop 1" : "+v"(a), "+v"(b)); }
__device__ __forceinline__ void swap16(float& a, float& b) { asm volatile("s_nop 1\n\tv_permlane16_swap_b32 %0, %1\n\ts_nop 1" : "+v"(a), "+v"(b)); }
__device__ __forceinline__ float x32_sum(float v) { float a = v, b = v; swap32(a, b); return a + b; }
__device__ __forceinline__ float x32_max(float v) { float a = v, b = v; swap32(a, b); return fmaxf(a, b); }
__device__ __forceinline__ float x16_sum(float v) { float a = v, b = v; swap16(a, b); return a + b; }
__device__ __forceinline__ float dpp_add(float v, const int ctrl_sel) {
    int t;
    if (ctrl_sel == 0) t = __builtin_amdgcn_mov_dpp(__builtin_bit_cast(int, v), 0xB1, 0xf, 0xf, true);
    else if (ctrl_sel == 1) t = __builtin_amdgcn_mov_dpp(__builtin_bit_cast(int, v), 0x4E, 0xf, 0xf, true);
    else if (ctrl_sel == 2) t = __builtin_amdgcn_mov_dpp(__builtin_bit_cast(int, v), 0x141, 0xf, 0xf, true);
    else t = __builtin_amdgcn_mov_dpp(__builtin_bit_cast(int, v), 0x140, 0xf, 0xf, true);
    return v + __builtin_bit_cast(float, t);
}
__device__ __forceinline__ float dpp_max(float v, const int ctrl_sel) {
    int t;
    if (ctrl_sel == 0) t = __builtin_amdgcn_mov_dpp(__builtin_bit_cast(int, v), 0xB1, 0xf, 0xf, true);
    else if (ctrl_sel == 1) t = __builtin_amdgcn_mov_dpp(__builtin_bit_cast(int, v), 0x4E, 0xf, 0xf, true);
    else if (ctrl_sel == 2) t = __builtin_amdgcn_mov_dpp(__builtin_bit_cast(int, v), 0x141, 0xf, 0xf, true);
    else t = __builtin_amdgcn_mov_dpp(__builtin_bit_cast(int, v), 0x140, 0xf, 0xf, true);
    return fmaxf(v, __builtin_bit_cast(float, t));
}
__device__ __forceinline__ float wave_max(float v) { v = dpp_max(v, 0); v = dpp_max(v, 1); v = dpp_max(v, 2); v = dpp_max(v, 3); { float a = v, b = v; swap16(a, b); v = fmaxf(a, b); } return x32_max(v); }
__device__ __forceinline__ float wave_sum(float v) { v = dpp_add(v, 0); v = dpp_add(v, 1); v = dpp_add(v, 2); v = dpp_add(v, 3); v = x16_sum(v); return x32_sum(v); }

namespace pg8 {
#define PG8_LAS __attribute__((address_space(3)))
constexpr int BM = 256, BK = 64, HALF = 128, HTB = HALF * BK * 2, STAGE_BYTES = 8 * HTB, NXCD = 8, WGM = 8;
__host__ __device__ __forceinline__ int lds_byte(int r, int c) { const int st = (r >> 4) * 2 + (c >> 5), rr = r & 15, cc = c & 31, ob = rr * 64 + cc * 2; return st * 1024 + (ob ^ (((ob >> 9) & 1) << 5)); }
__host__ __device__ __forceinline__ void stage_rc(int b, int& R, int& C) { const int st = b / 1024, sb = b % 1024, swz = sb ^ (((sb >> 9) & 1) << 5); R = (st >> 1) * 16 + swz / 64; C = (st & 1) * 32 + (swz % 64) / 2; }
__host__ __device__ __forceinline__ int perm32(int rho) { const int n = rho >> 4, i = rho & 15; return 8 * (i >> 2) + 4 * n + (i & 3); }
struct Unit { int pm, pn; };
struct Gemm { const bf16_t* A; const bf16_t* Bt; int M, N, K; };
struct StaticOrder {
    int nM, nN, nwg, G, c;
    __host__ __device__ void init(int M, int N, int G_, int c_) { nM = M / BM; nN = N / BM; nwg = nM * nN; G = G_; c = c_; }
    __host__ __device__ bool next(int i, Unit& u) const {
        const long L = (long)i * G + c; if (L >= nwg) return false;
        int wgid = (int)L; { const int q = nwg / NXCD, r = nwg % NXCD, xcd = wgid % NXCD, off = wgid / NXCD; wgid = (xcd < r ? xcd * (q + 1) : r * (q + 1) + (xcd - r) * q) + off; }
        const int nig = WGM * nN, gid = wgid / nig, fm = gid * WGM, gsz = (nM - fm) < WGM ? (nM - fm) : WGM;
        u.pm = fm + ((wgid % nig) % gsz); u.pn = (wgid % nig) / gsz; return true;
    }
    __device__ __forceinline__ void a_ready(const Unit&) const {}
    __device__ __forceinline__ void done(const Unit&) const {}
};
template <class Epi, class Sched, bool ALIGN_EPI = false, bool SP2 = false>
__device__ __forceinline__ void gemm_phase(PG8_LAS unsigned char* lds, const Gemm g, const Sched& S, const Epi& E) {
    int tid = threadIdx.x; asm volatile("" : "+v"(tid));
    const int wid = __builtin_amdgcn_readfirstlane(tid >> 6), lane = tid & 63, wr = wid >> 2, wc = wid & 3, fr = lane & 15, fq = lane >> 4;
    const int K = g.K, nt = K / BK;
    unsigned voffA[2], voffB[2];
#pragma unroll
    for (int i = 0; i < 2; ++i) { int R, C; stage_rc(tid * 16 + i * 8192, R, C); const int Rb = Epi::PERM ? ((R & ~31) + perm32(R & 31)) : R;
        voffA[i] = (unsigned)(R * K + C) * 2u; voffB[i] = (unsigned)(Rb * K + C) * 2u; }
    const size_t kstep = (size_t)(BK * 2);
    const size_t hstep = (size_t)HALF * K * 2;
    const size_t tstep = 2 * hstep;
    const unsigned ldsw = (unsigned)wid * 1024u;
    const int aoff = lds_byte(wr * 64 + fr, fq * 8), boff = lds_byte(wc * 32 + fr, fq * 8);
#define PG8_SA(b, h) (((b) * 2 + (h)) * HTB)
#define PG8_SB(b, h) ((4 + (b) * 2 + (h)) * HTB)
#define PG8_STAGE(bufoff, gbase, voff) do { _Pragma("unroll") for (int _i = 0; _i < 2; ++_i) \
        __builtin_amdgcn_global_load_lds((const unsigned*)((const char*)(gbase) + (voff)[_i]), (PG8_LAS unsigned*)(lds + (bufoff) + ldsw + _i * 8192), 16, 0, 0); } while (0)
#define PG8_LDA(dst, b, h) do { _Pragma("unroll") for (int m = 0; m < 4; ++m) _Pragma("unroll") for (int k = 0; k < 2; ++k) dst[m][k] = *(const PG8_LAS bf16x8*)(lds + PG8_SA(b, h) + aoff + m * 2048 + k * 1024); } while (0)
#define PG8_LDB(dst, b, h) do { _Pragma("unroll") for (int n = 0; n < 2; ++n) _Pragma("unroll") for (int k = 0; k < 2; ++k) dst[n][k] = *(const PG8_LAS bf16x8*)(lds + PG8_SB(b, h) + boff + n * 2048 + k * 1024); } while (0)
#define PG8_MMA(ai, bj, At, Bt) do { __builtin_amdgcn_s_setprio(1); _Pragma("unroll") for (int m = 0; m < 4; ++m) _Pragma("unroll") for (int n = 0; n < 2; ++n) _Pragma("unroll") for (int k = 0; k < 2; ++k) \
        acc[ai][bj][m][n] = __builtin_amdgcn_mfma_f32_16x16x32_bf16(Bt[n][k], At[m][k], acc[ai][bj][m][n], 0, 0, 0); __builtin_amdgcn_s_setprio(0); } while (0)
#define PG8_WAIT_V(n) asm volatile("s_waitcnt vmcnt(" #n ")" ::: "memory")
#define PG8_WAIT_L(n) asm volatile("s_waitcnt lgkmcnt(" #n ")" ::: "memory")
#define PG8_BAR __builtin_amdgcn_s_barrier()
#define PG8_SCHED __builtin_amdgcn_sched_barrier(0)
    Unit cur, nxt; int ui = 0;
    if (!S.next(0, cur)) return;
    f32x4 acc[2][2][4][2];
#pragma unroll
    for (int a = 0; a < 2; ++a)
#pragma unroll
        for (int b = 0; b < 2; ++b)
#pragma unroll
            for (int m = 0; m < 4; ++m)
#pragma unroll
                for (int n = 0; n < 2; ++n) acc[a][b][m][n] = (f32x4){0.f, 0.f, 0.f, 0.f};
    bf16x8 At[4][2], B0[2][2], B1[2][2];
    const char* cA = (const char*)g.A + (size_t)cur.pm * tstep; const char* cB = (const char*)g.Bt + (size_t)cur.pn * tstep;
    S.a_ready(cur);
    if constexpr (SP2) {
        PG8_STAGE(PG8_SB(0, 0), cB, voffB); PG8_STAGE(PG8_SB(0, 1), cB + hstep, voffB); PG8_STAGE(PG8_SA(0, 0), cA, voffA); PG8_STAGE(PG8_SA(0, 1), cA + hstep, voffA);
        if (wr == 1) PG8_BAR;
        PG8_WAIT_V(2); PG8_BAR;
        PG8_STAGE(PG8_SB(1, 0), cB + kstep, voffB); PG8_STAGE(PG8_SA(1, 0), cA + kstep, voffA); PG8_STAGE(PG8_SB(1, 1), cB + hstep + kstep, voffB);
        PG8_WAIT_V(6); PG8_BAR;
    } else {
        PG8_STAGE(PG8_SB(0, 0), cB, voffB); PG8_STAGE(PG8_SA(0, 0), cA, voffA); PG8_STAGE(PG8_SB(0, 1), cB + hstep, voffB); PG8_STAGE(PG8_SA(0, 1), cA + hstep, voffA);
        if (wr == 1) PG8_BAR;
        PG8_WAIT_V(4); PG8_BAR;
        PG8_STAGE(PG8_SB(1, 0), cB + kstep, voffB); PG8_STAGE(PG8_SA(1, 0), cA + kstep, voffA); PG8_STAGE(PG8_SB(1, 1), cB + hstep + kstep, voffB);
        PG8_WAIT_V(6); PG8_BAR;
    }
    for (;;) {
        const bool has_next = S.next(ui + 1, nxt);
        const char* nA = has_next ? (const char*)g.A + (size_t)nxt.pm * tstep : cA; const char* nB = has_next ? (const char*)g.Bt + (size_t)nxt.pn * tstep : cB;
        for (int t = 0; t < nt; t += 2) {
            const bool last = (t == nt - 2);
            const char* a1 = cA + (size_t)(t + 1) * kstep;
            const char* a2 = last ? nA : cA + (size_t)(t + 2) * kstep; const char* b2 = last ? nB : cB + (size_t)(t + 2) * kstep;
            const char* a3 = a2 + kstep; const char* b3 = b2 + kstep;
            if (last && has_next) S.a_ready(nxt);
            if constexpr (SP2) {
            PG8_LDB(B0, 0, 0); PG8_LDB(B1, 0, 1); PG8_SCHED; PG8_LDA(At, 0, 0); PG8_STAGE(PG8_SA(1, 1), a1 + hstep, voffA);
            PG8_WAIT_V(8); PG8_WAIT_L(0); PG8_BAR; PG8_MMA(0, 0, At, B0); PG8_MMA(0, 1, At, B1); PG8_BAR; PG8_SCHED;
            PG8_LDA(At, 0, 1); PG8_STAGE(PG8_SB(0, 0), b2, voffB); PG8_STAGE(PG8_SB(0, 1), b2 + hstep, voffB); PG8_STAGE(PG8_SA(0, 0), a2, voffA);
            PG8_WAIT_V(8); PG8_WAIT_L(0); PG8_BAR; PG8_MMA(1, 0, At, B0); PG8_MMA(1, 1, At, B1); PG8_BAR; PG8_SCHED;
            PG8_LDB(B0, 1, 0); PG8_LDB(B1, 1, 1); PG8_SCHED; PG8_LDA(At, 1, 0); PG8_STAGE(PG8_SA(0, 1), a2 + hstep, voffA);
            PG8_WAIT_V(8); PG8_WAIT_L(0); PG8_BAR; PG8_MMA(0, 0, At, B0); PG8_MMA(0, 1, At, B1); PG8_BAR; PG8_SCHED;
            PG8_LDA(At, 1, 1); PG8_STAGE(PG8_SB(1, 0), b3, voffB); PG8_STAGE(PG8_SB(1, 1), b3 + hstep, voffB); PG8_STAGE(PG8_SA(1, 0), a3, voffA);
            PG8_WAIT_V(8); PG8_WAIT_L(0); PG8_BAR; PG8_MMA(1, 0, At, B0); PG8_MMA(1, 1, At, B1); PG8_BAR; PG8_SCHED;
            } else {
            PG8_LDB(B0, 0, 0); PG8_SCHED; PG8_LDA(At, 0, 0); PG8_STAGE(PG8_SA(1, 1), a1 + hstep, voffA);
            PG8_WAIT_L(8); PG8_BAR; PG8_WAIT_L(0); PG8_MMA(0, 0, At, B0); PG8_BAR; PG8_SCHED;
            PG8_LDB(B1, 0, 1); PG8_STAGE(PG8_SB(0, 0), b2, voffB);
            PG8_BAR; PG8_WAIT_L(0); PG8_MMA(0, 1, At, B1); PG8_BAR;
            PG8_LDA(At, 0, 1); PG8_STAGE(PG8_SA(0, 0), a2, voffA);
            PG8_BAR; PG8_WAIT_L(0); PG8_MMA(1, 0, At, B0); PG8_BAR; PG8_SCHED;
            PG8_STAGE(PG8_SB(0, 1), b2 + hstep, voffB);
            PG8_WAIT_V(6); PG8_BAR; PG8_MMA(1, 1, At, B1); PG8_BAR;
            PG8_LDB(B0, 1, 0); PG8_SCHED; PG8_LDA(At, 1, 0); PG8_STAGE(PG8_SA(0, 1), a2 + hstep, voffA);
            PG8_WAIT_L(8); PG8_BAR; PG8_WAIT_L(0); PG8_MMA(0, 0, At, B0); PG8_BAR; PG8_SCHED;
            PG8_LDB(B1, 1, 1); PG8_STAGE(PG8_SB(1, 0), b3, voffB);
            PG8_BAR; PG8_WAIT_L(0); PG8_MMA(0, 1, At, B1); PG8_BAR;
            PG8_LDA(At, 1, 1); PG8_STAGE(PG8_SA(1, 0), a3, voffA);
            PG8_BAR; PG8_WAIT_L(0); PG8_MMA(1, 0, At, B0); PG8_BAR; PG8_SCHED;
            PG8_STAGE(PG8_SB(1, 1), b3 + hstep, voffB);
            PG8_WAIT_V(6); PG8_BAR; PG8_MMA(1, 1, At, B1); PG8_BAR;
            }
        }
        if constexpr (ALIGN_EPI) { if (wr == 0) PG8_BAR; }
        E(acc, cur, wr, wc, fr, fq); S.done(cur);
        if (!has_next) break;
#pragma unroll
        for (int a = 0; a < 2; ++a)
#pragma unroll
            for (int b = 0; b < 2; ++b)
#pragma unroll
                for (int m = 0; m < 4; ++m)
#pragma unroll
                    for (int n = 0; n < 2; ++n) acc[a][b][m][n] = (f32x4){0.f, 0.f, 0.f, 0.f};
        cur = nxt; cA = nA; cB = nB; ++ui;
        if constexpr (ALIGN_EPI) { if (wr == 1) PG8_BAR; }
    }
    PG8_WAIT_V(0);
    if constexpr (!ALIGN_EPI) { if (wr == 0) PG8_BAR; }
    PG8_BAR;
#undef PG8_SA
#undef PG8_SB
#undef PG8_STAGE
#undef PG8_LDA
#undef PG8_LDB
#undef PG8_MMA
#undef PG8_WAIT_V
#undef PG8_WAIT_L
#undef PG8_BAR
#undef PG8_SCHED
}
}

typedef const f32x4 (&AccRef)[2][2][4][2];
__device__ __forceinline__ void st8_bf16(bf16_t* p, f32x4 a, f32x4 b) { u32x4 w; w.x = cvt_pk_bf16(a[0], a[1]); w.y = cvt_pk_bf16(a[2], a[3]); w.z = cvt_pk_bf16(b[0], b[1]); w.w = cvt_pk_bf16(b[2], b[3]); *(u32x4*)p = w; }
__device__ __forceinline__ void ld8_bf16(const bf16_t* p, f32x4& a, f32x4& b) { const u32x4 w = *(const u32x4*)p;
    a = (f32x4){__builtin_bit_cast(float, w.x << 16), __builtin_bit_cast(float, w.x & 0xffff0000u), __builtin_bit_cast(float, w.y << 16), __builtin_bit_cast(float, w.y & 0xffff0000u)};
    b = (f32x4){__builtin_bit_cast(float, w.z << 16), __builtin_bit_cast(float, w.z & 0xffff0000u), __builtin_bit_cast(float, w.w << 16), __builtin_bit_cast(float, w.w & 0xffff0000u)}; }

struct EpiG1 {
    static constexpr bool PERM = true;
    bf16_t *QA, *KA, *VA, *QB, *KB, *VB, *GATE; float* out; int layer;
    const float *qn_a, *kn_a, *qn_b, *kn_b;
    __device__ __forceinline__ void operator()(AccRef acc, const pg8::Unit& u, int wr, int wc, int fr, int fq) const {
        const int pn = u.pn, lc = pn * 256 + wc * 64 + fq * 8;
        const bool samp = (u.pm >= 128);
        int mode; const float* g = nullptr; float scale = 1.f; bf16_t* dst; int pitch, cb, rowmap; float* fo = nullptr; int fpitch = 0;
        if (pn < 4)       { mode = 0; g = qn_a; scale = C2; dst = QA; pitch = 1024; cb = lc; rowmap = 0; }
        else if (pn < 8)  { mode = 0; g = kn_a; dst = KA; pitch = 1024; cb = lc - 1024; rowmap = 1; fpitch = 1024; fo = out + (samp ? O_AK_S + (size_t)layer * 262144 : O_AK_P + (size_t)layer * 33554432); }
        else if (pn < 12) { mode = 1; dst = VA; pitch = 1024; cb = lc - 2048; rowmap = 1; fpitch = 1024; fo = out + (samp ? O_AV_S + (size_t)layer * 262144 : O_AV_P + (size_t)layer * 33554432); }
        else if (pn < 14) { mode = 0; g = qn_b; scale = C2; dst = QB; pitch = 512; cb = lc - 3072; rowmap = 0; }
        else if (pn < 16) { mode = 0; g = kn_b; dst = KB; pitch = 512; cb = lc - 3584; rowmap = 2; fpitch = 512;
                            if (samp) fo = out + O_BK_S + (size_t)layer * 131072; else if ((u.pm & 63) >= 62) fo = out + O_BK_P + (size_t)layer * 524288; }
        else if (pn < 18) { mode = 1; dst = VB; pitch = 512; cb = lc - 4096; rowmap = 2; fpitch = 512;
                            if (samp) fo = out + O_BV_S + (size_t)layer * 131072; else if ((u.pm & 63) >= 62) fo = out + O_BV_P + (size_t)layer * 524288; }
        else              { mode = 2; dst = GATE; pitch = 2048; cb = lc - 4608; rowmap = 0; }
        float one = 1.f; asm volatile("" : "+v"(one));
        f32x4 gv[2][2];
        if (mode == 0) {
#pragma unroll
            for (int bj = 0; bj < 2; ++bj)
#pragma unroll
                for (int n = 0; n < 2; ++n) gv[bj][n] = *(const f32x4*)(g + bj * 32 + fq * 8 + n * 4) * scale;
        }
#pragma unroll
        for (int ai = 0; ai < 2; ++ai)
#pragma unroll
            for (int m = 0; m < 4; ++m) {
                const int row = u.pm * 256 + ai * 128 + wr * 64 + m * 16 + fr;
                f32x4 v[2][2];
#pragma unroll
                for (int bj = 0; bj < 2; ++bj)
#pragma unroll
                    for (int n = 0; n < 2; ++n) v[bj][n] = acc[ai][bj][m][n];
                if (mode == 0) {
                    float ss = 0.f;
#pragma unroll
                    for (int bj = 0; bj < 2; ++bj)
#pragma unroll
                        for (int n = 0; n < 2; ++n) { const f32x4 x = v[bj][n]; ss += (x[0] * x[0] + x[1] * x[1]) + (x[2] * x[2] + x[3] * x[3]); }
                    ss = x16_sum(ss); ss = x32_sum(ss);
                    const float rs = __builtin_amdgcn_rsqf(ss * (1.f / 64.f) + EPS);
#pragma unroll
                    for (int bj = 0; bj < 2; ++bj)
#pragma unroll
                        for (int n = 0; n < 2; ++n) v[bj][n] = v[bj][n] * rs * gv[bj][n];
                } else if (mode == 1) {
#pragma unroll
                    for (int bj = 0; bj < 2; ++bj)
#pragma unroll
                        for (int n = 0; n < 2; ++n) v[bj][n] = v[bj][n] * one;
                } else {
#pragma unroll
                    for (int bj = 0; bj < 2; ++bj)
#pragma unroll
                        for (int n = 0; n < 2; ++n)
#pragma unroll
                            for (int i = 0; i < 4; ++i) v[bj][n][i] = __builtin_amdgcn_rcpf(1.f + __builtin_amdgcn_exp2f(-LOG2E * v[bj][n][i]));
                }
                size_t drow;
                if (rowmap == 0 || !samp) drow = (size_t)row;
                else { const int r = row - MP, s = r >> 4, t = r & 15; drow = (rowmap == 1) ? (size_t)(MP + s * SA_LEN + 2048 + t) : (size_t)(MP + s * SB_LEN + 512 + t); }
                bf16_t* dp = dst + drow * pitch + cb;
#pragma unroll
                for (int bj = 0; bj < 2; ++bj) st8_bf16(dp + bj * 32, v[bj][0], v[bj][1]);
                if (fo) {
                    size_t frow;
                    if (samp) frow = (size_t)(row - MP);
                    else if (fpitch == 1024) frow = (size_t)row;
                    else frow = (size_t)((row >> 14) * 512 + (row & 16383) - 15872);
                    float* fp = fo + frow * fpitch + cb;
#pragma unroll
                    for (int bj = 0; bj < 2; ++bj) { *(f32x4*)(fp + bj * 32) = v[bj][0]; *(f32x4*)(fp + bj * 32 + 4) = v[bj][1]; }
                }
            }
    }
};
template <bool ADD> struct EpiGate {
    static constexpr bool PERM = true;
    bf16_t* Mb; const bf16_t* gate;
    __device__ __forceinline__ void operator()(AccRef acc, const pg8::Unit& u, int wr, int wc, int fr, int fq) const {
        const int lc = u.pn * 256 + wc * 64 + fq * 8;
#pragma unroll
        for (int ai = 0; ai < 2; ++ai)
#pragma unroll
            for (int m = 0; m < 4; ++m) {
                const size_t row = (size_t)(u.pm * 256 + ai * 128 + wr * 64 + m * 16 + fr);
#pragma unroll
                for (int bj = 0; bj < 2; ++bj) {
                    f32x4 g0, g1; ld8_bf16(gate + row * 2048 + lc + bj * 32, g0, g1);
                    f32x4 v0 = acc[ai][bj][m][0] * g0, v1 = acc[ai][bj][m][1] * g1;
                    bf16_t* mp = Mb + row * 1024 + lc + bj * 32;
                    if (ADD) { f32x4 p0, p1; ld8_bf16(mp, p0, p1); v0 += p0; v1 += p1; }
                    st8_bf16(mp, v0, v1);
                }
            }
    }
};
struct EpiResid {
    static constexpr bool PERM = true;
    const float* srcP; const float* srcS; float* dst;
    __device__ __forceinline__ void operator()(AccRef acc, const pg8::Unit& u, int wr, int wc, int fr, int fq) const {
        const int lc = u.pn * 256 + wc * 64 + fq * 8;
        const float* sb = (u.pm >= 128) ? srcS - (size_t)MP * 1024 : srcP;
#pragma unroll
        for (int ai = 0; ai < 2; ++ai)
#pragma unroll
            for (int m = 0; m < 4; ++m) {
                const size_t off = (size_t)(u.pm * 256 + ai * 128 + wr * 64 + m * 16 + fr) * 1024 + lc;
#pragma unroll
                for (int bj = 0; bj < 2; ++bj)
#pragma unroll
                    for (int n = 0; n < 2; ++n) { const f32x4 s = *(const f32x4*)(sb + off + bj * 32 + n * 4); *(f32x4*)(dst + off + bj * 32 + n * 4) = s + acc[ai][bj][m][n]; }
            }
    }
};
struct EpiRelu2 {
    static constexpr bool PERM = true;
    bf16_t* U;
    __device__ __forceinline__ void operator()(AccRef acc, const pg8::Unit& u, int wr, int wc, int fr, int fq) const {
        const int lc = u.pn * 256 + wc * 64 + fq * 8;
#pragma unroll
        for (int ai = 0; ai < 2; ++ai)
#pragma unroll
            for (int m = 0; m < 4; ++m) {
                bf16_t* up = U + (size_t)(u.pm * 256 + ai * 128 + wr * 64 + m * 16 + fr) * DFF + lc;
#pragma unroll
                for (int bj = 0; bj < 2; ++bj) { f32x4 a = acc[ai][bj][m][0], b = acc[ai][bj][m][1];
#pragma unroll
                    for (int i = 0; i < 4; ++i) { const float x = fmaxf(a[i], 0.f), y = fmaxf(b[i], 0.f); a[i] = x * x; b[i] = y * y; }
                    st8_bf16(up + bj * 32, a, b); }
            }
    }
};

struct AUnit { int qrow0, kvrow0, qloc0, nq, nk, h, jlo, jhi; };
#define MFMA32(a, b, c) __builtin_amdgcn_mfma_f32_32x32x16_bf16((a), (b), (c), 0, 0, 0)
__device__ __forceinline__ s16x4 vtr(const LAS unsigned char* p) { return __builtin_bit_cast(s16x4, __builtin_amdgcn_ds_read_tr16_b64_v4i16((LAS s16x4*)p)); }

template <bool DIFF, bool FIXED, bool F32SRC>
__device__ __forceinline__ void attn_unit(LAS unsigned char* lds, const bf16_t* Q, const bf16_t* __restrict__ K, const bf16_t* __restrict__ V, bf16_t* O, const AUnit u,
                                          const float* __restrict__ kc, const float* __restrict__ vc, const float* __restrict__ kn, const float* __restrict__ vn,
                                          const int win, const float slopeL2, const float lam, const float* subln_g, const float osc, const LAS float* tab, const float mref0) {
    constexpr int HW = DIFF ? 128 : 64, PITCH = DIFF ? 1024 : 512, NDB = HW / 32, NCH = HW / 64, RB = HW * 2;
    constexpr int KBUF = 64 * RB, VBUF = 64 * RB, BUF = KBUF + VBUF;
    int tid = threadIdx.x; asm volatile("" : "+v"(tid));
    const int lane = tid & 63, w = __builtin_amdgcn_readfirstlane(tid >> 6), q32 = lane & 31, hi = lane >> 5;
    const int sub = DIFF ? (w & 1) : 0, qg = DIFF ? (w >> 1) : w;
    const bool wact = (32 * qg < u.nq);
    const int qloc = u.qloc0 + 32 * qg + q32, cq = (u.qloc0 + 32 * qg) >> 6;
    const bool qvalid = (32 * qg + q32) < u.nq;
    const int qrow = qvalid ? (u.qrow0 + 32 * qg + q32) : u.qrow0;
    bf16x8 qf[4];
#pragma unroll
    for (int ks = 0; ks < 4; ++ks) qf[ks] = *(const bf16x8*)(Q + (size_t)qrow * PITCH + u.h * HW + sub * 64 + ks * 16 + hi * 8);
    float mrun = mref0, lrun = 0.f; f32x16 o[NDB];
#pragma unroll
    for (int db = 0; db < NDB; ++db) o[db] = f32x16{};
    unsigned kgo[NCH], vgo[NCH];
#pragma unroll
    for (int i = 0; i < NCH; ++i) {
        const int piece = w * NCH + i;
        const int krow = DIFF ? (piece * 4 + (lane >> 4)) : (piece * 8 + (lane >> 3));
        const int kcp = DIFF ? (lane & 15) : (lane & 7);
        const int kch = kcp ^ (DIFF ? (krow & 15) : ((krow >> 1) & 7));
        kgo[i] = (unsigned)(krow * PITCH + kch * 8);
        const int p = piece * 64 + lane, st = p >> 5, key = 8 * (st / NDB) + ((p & 31) >> 2), dch = (st % NDB) * 4 + (p & 3);
        vgo[i] = (unsigned)(key * PITCH + dch * 8);
    }
#define ATT_DMA(j, b) do { const bf16_t* kt_ = K + (size_t)(u.kvrow0 + 64 * (j)) * PITCH + u.h * HW; const bf16_t* vt_ = V + (size_t)(u.kvrow0 + 64 * (j)) * PITCH + u.h * HW; \
        _Pragma("unroll") for (int i = 0; i < NCH; ++i) { \
            __builtin_amdgcn_global_load_lds((const unsigned*)(kt_ + kgo[i]), (LAS unsigned*)(lds + (b) * BUF + (w * NCH + i) * 1024), 16, 0, 0); \
            __builtin_amdgcn_global_load_lds((const unsigned*)(vt_ + vgo[i]), (LAS unsigned*)(lds + (b) * BUF + KBUF + (w * NCH + i) * 1024), 16, 0, 0); } } while (0)
#define ATT_WAIT_BAR(n) asm volatile("s_waitcnt vmcnt(" #n ")\n\ts_barrier" ::: "memory")
    const int vlane = (4 * hi + ((lane & 15) >> 2)) * 64 + ((lane >> 4) & 1) * 32 + (lane & 3) * 8;
    const int kswz = DIFF ? (q32 & 15) : ((q32 >> 1) & 7);
    int koff[4];
#pragma unroll
    for (int ks = 0; ks < 4; ++ks) koff[ks] = q32 * RB + (((sub * 8 + 2 * ks + hi) ^ kswz) << 4);
    int j = u.jhi, buf = 0;
    if (!F32SRC) {
    asm volatile("s_waitcnt vmcnt(0)" ::: "memory");
    ATT_DMA(j, 0);
    if (j - 1 >= u.jlo) { ATT_DMA(j - 1, 1); if (NCH == 2) ATT_WAIT_BAR(4); else ATT_WAIT_BAR(2); }
    else ATT_WAIT_BAR(0);
    }
    for (; j >= u.jlo; --j) {
        if (F32SRC) {
#pragma unroll
            for (int i = 0; i < NCH; ++i) {
                const int c = tid + 512 * i, row = c / (HW / 8), ch = c % (HW / 8);
                const size_t so = (j == u.jhi) ? (size_t)min(row, 15) * PITCH + u.h * HW + ch * 8 : (size_t)(64 * j + row) * PITCH + u.h * HW + ch * 8;
                const float* ks_ = ((j == u.jhi) ? kn : kc) + so; const float* vs_ = ((j == u.jhi) ? vn : vc) + so;
                const f32x4 k0 = ((const f32x4*)ks_)[0], k1 = ((const f32x4*)ks_)[1], v0 = ((const f32x4*)vs_)[0], v1 = ((const f32x4*)vs_)[1];
                u32x4 kw, vw; kw.x = pk2(k0.x, k0.y); kw.y = pk2(k0.z, k0.w); kw.z = pk2(k1.x, k1.y); kw.w = pk2(k1.z, k1.w); vw.x = pk2(v0.x, v0.y); vw.y = pk2(v0.z, v0.w); vw.z = pk2(v1.x, v1.y); vw.w = pk2(v1.z, v1.w);
                *(LAS u32x4*)(lds + buf * BUF + row * RB + ((ch ^ (DIFF ? (row & 15) : ((row >> 1) & 7))) << 4)) = kw;
                *(LAS u32x4*)(lds + buf * BUF + KBUF + (row >> 3) * (NDB * 512) + (ch >> 2) * 512 + (row & 7) * 64 + (ch & 3) * 16) = vw;
            }
            __syncthreads();
        } else {
        const int b2 = (buf >= 1) ? buf - 1 : 2;
        if (j - 2 >= u.jlo) ATT_DMA(j - 2, b2);
        }
        const bool comp = (wact && j <= cq && j >= cq - win);
        if (comp) {
            const LAS unsigned char* kb = lds + buf * BUF; const LAS unsigned char* vb = kb + KBUF;
            const int dqi = qloc - 64 * j - 4 * hi; const float dq = (float)dqi;
            bf16x8 kf0[2], kf1[2];
#pragma unroll
            for (int ks = 0; ks < 2; ++ks) { kf0[ks] = *(const LAS bf16x8*)(kb + koff[ks]); kf1[ks] = *(const LAS bf16x8*)(kb + koff[ks] + 32 * RB); }
            f32x16 a0, a1;
            if (DIFF) {
                if (j < cq) {
                    const float base = -slopeL2 * dq - mrun;
#pragma unroll
                    for (int r = 0; r < 16; ++r) { const float c = (float)((r & 3) + 8 * (r >> 2)); a0[r] = slopeL2 * c + base; a1[r] = slopeL2 * (c + 32.f) + base; }
                } else {
#pragma unroll
                    for (int r = 0; r < 16; ++r) { const float c = (float)((r & 3) + 8 * (r >> 2)); a0[r] = -slopeL2 * __builtin_fabsf(dq - c) - mrun; a1[r] = -slopeL2 * __builtin_fabsf(dq - (c + 32.f)) - mrun; }
                }
            } else {
                if (j <= cq - 3) {
                    const float t = tab[256] - mrun;
#pragma unroll
                    for (int r = 0; r < 16; ++r) { a0[r] = t; a1[r] = t; }
                } else {
#pragma unroll
                    for (int r = 0; r < 16; ++r) { const int c = (r & 3) + 8 * (r >> 2); int i0 = dqi - c, i1 = dqi - c - 32;
                        i0 = min(max(i0, -128), 128) + 128; i1 = min(max(i1, -128), 128) + 128; a0[r] = tab[i0] - mrun; a1[r] = tab[i1] - mrun; }
                }
            }
            if (64 * j + 64 > u.nk) {
#pragma unroll
                for (int r = 0; r < 16; ++r) { const int key = 64 * j + (r & 3) + 8 * (r >> 2) + 4 * hi; if (key >= u.nk) a0[r] = -1e30f; if (key + 32 >= u.nk) a1[r] = -1e30f; }
            }
            __builtin_amdgcn_sched_barrier(0);
#pragma unroll
            for (int ks = 0; ks < 2; ++ks) { a0 = MFMA32(kf0[ks], qf[ks], a0); a1 = MFMA32(kf1[ks], qf[ks], a1); }
            __builtin_amdgcn_sched_barrier(0);
#pragma unroll
            for (int ks = 0; ks < 2; ++ks) { kf0[ks] = *(const LAS bf16x8*)(kb + koff[ks + 2]); kf1[ks] = *(const LAS bf16x8*)(kb + koff[ks + 2] + 32 * RB); }
            __builtin_amdgcn_sched_barrier(0);
#pragma unroll
            for (int ks = 0; ks < 2; ++ks) { a0 = MFMA32(kf0[ks], qf[ks + 2], a0); a1 = MFMA32(kf1[ks], qf[ks + 2], a1); }
            __builtin_amdgcn_sched_barrier(0);
            bf16x8 vf[4];
#define ATT_VLOAD(dst, db) do { _Pragma("unroll") for (int ks = 0; ks < 4; ++ks) { \
                const s16x4 lo_ = vtr(vb + (2 * ks) * (NDB * 512) + (db) * 512 + vlane), h4_ = vtr(vb + (2 * ks + 1) * (NDB * 512) + (db) * 512 + vlane); \
                dst[ks] = (bf16x8){lo_[0], lo_[1], lo_[2], lo_[3], h4_[0], h4_[1], h4_[2], h4_[3]}; } } while (0)
            if (!FIXED) {
            float mx = fmaxf(fmaxf(a0[0], a1[0]), fmaxf(a0[1], a1[1]));
#pragma unroll
            for (int r = 2; r < 16; r += 2) mx = fmaxf(fmaxf(mx, fmaxf(a0[r], a1[r])), fmaxf(a0[r + 1], a1[r + 1]));
            mx = x32_max(mx);
            if (__any(mx > 0.f)) {
                const float dl = fmaxf(mx, 0.f), al = __builtin_amdgcn_exp2f(-dl);
                lrun *= al; mrun += dl;
#pragma unroll
                for (int r = 0; r < 16; ++r) { a0[r] -= dl; a1[r] -= dl; }
#pragma unroll
                for (int db = 0; db < NDB; ++db)
#pragma unroll
                    for (int r = 0; r < 16; ++r) o[db][r] *= al;
            }
            }
            float ls = 0.f;
#pragma unroll
            for (int r = 0; r < 16; ++r) { a0[r] = __builtin_amdgcn_exp2f(a0[r]); a1[r] = __builtin_amdgcn_exp2f(a1[r]); ls += a0[r] + a1[r]; }
            lrun += ls;
            bf16x8 pf[4];
#pragma unroll
            for (int ks = 0; ks < 4; ++ks) { u32x4 p;
#pragma unroll
                for (int e = 0; e < 4; ++e) p[e] = (ks < 2) ? cvt_pk_bf16(a0[8 * ks + 2 * e], a0[8 * ks + 2 * e + 1]) : cvt_pk_bf16(a1[8 * (ks - 2) + 2 * e], a1[8 * (ks - 2) + 2 * e + 1]);
                pf[ks] = __builtin_bit_cast(bf16x8, p); }
#pragma unroll
            for (int db = 0; db < NDB; ++db) {
                ATT_VLOAD(vf, db);
                __builtin_amdgcn_sched_barrier(0);
#pragma unroll
                for (int ks = 0; ks < 4; ++ks) o[db] = MFMA32(vf[ks], pf[ks], o[db]);
                __builtin_amdgcn_sched_barrier(0);
            }
#undef ATT_VLOAD
        }
        if (F32SRC) buf ^= 1;
        else {
        if (j - 2 >= u.jlo) { if (NCH == 2) ATT_WAIT_BAR(4); else ATT_WAIT_BAR(2); }
        else ATT_WAIT_BAR(0);
        buf = (buf == 2) ? 0 : buf + 1;
        }
    }
    if (F32SRC) __syncthreads();
#undef ATT_DMA
#undef ATT_WAIT_BAR
    const float lt = x32_sum(lrun);
    float sc = 1.f / lt;
    if (DIFF) {
        LAS f32x4* xch = (LAS f32x4*)lds;
        if (wact && sub == 1) {
            const float s1 = sc * lam;
#pragma unroll
            for (int db = 0; db < NDB; ++db)
#pragma unroll
                for (int r4 = 0; r4 < 4; ++r4) xch[((qg * NDB + db) * 4 + r4) * 64 + lane] = (f32x4){o[db][4 * r4], o[db][4 * r4 + 1], o[db][4 * r4 + 2], o[db][4 * r4 + 3]} * s1;
        }
        __syncthreads();
        if (wact && sub == 0) {
            float ss = 0.f;
#pragma unroll
            for (int db = 0; db < NDB; ++db)
#pragma unroll
                for (int r4 = 0; r4 < 4; ++r4) { const f32x4 p2 = xch[((qg * NDB + db) * 4 + r4) * 64 + lane];
#pragma unroll
                    for (int i = 0; i < 4; ++i) { const float v = o[db][4 * r4 + i] * sc - p2[i]; o[db][4 * r4 + i] = v; ss += v * v; } }
            ss = x32_sum(ss);
            sc = __builtin_amdgcn_rsqf(ss * (1.f / 128.f) + EPS) * osc;
        }
    }
    if (wact && sub == 0 && qvalid) {
        bf16_t* op = O + (size_t)qrow * PITCH + u.h * HW;
#pragma unroll
        for (int db = 0; db < NDB; ++db)
#pragma unroll
            for (int r4 = 0; r4 < 4; ++r4) {
                const int d = 32 * db + 8 * r4 + 4 * hi;
                f32x4 v = (f32x4){o[db][4 * r4], o[db][4 * r4 + 1], o[db][4 * r4 + 2], o[db][4 * r4 + 3]} * sc;
                if (DIFF) v = v * *(const f32x4*)(subln_g + d);
                u32x2 pk; pk.x = cvt_pk_bf16(v[0], v[1]); pk.y = cvt_pk_bf16(v[2], v[3]);
                *(u32x2*)(op + d) = pk;
            }
    }
    if (DIFF) __syncthreads();
}

__device__ __forceinline__ int prow(int R) { const int nl = R & 255; return (R & ~255) + 128 * ((nl >> 5) & 1) + 32 * (nl >> 6) + (nl & 31); }
__device__ __forceinline__ void transpose_item(const float* W, int K, int N, bf16_t* WT, int row_off, LAS float* scr, int item, int lane) {
    const int nblk = N / 32, kb = item / nblk, nb = item % nblk, k0 = 64 * kb, n0 = 32 * nb;
#pragma unroll 8
    for (int i = 0; i < 32; ++i) { const int kk = 2 * i + (lane >> 5); scr[kk * 33 + (lane & 31)] = W[(size_t)(k0 + kk) * N + n0 + (lane & 31)]; }
    asm volatile("s_waitcnt lgkmcnt(0)" ::: "memory");
    const int c = lane & 7;
#pragma unroll
    for (int j = 0; j < 4; ++j) { const int n = (lane >> 3) + 8 * j; const LAS float* s = scr + (8 * c) * 33 + n;
        u32x4 o; o.x = pk2(s[0 * 33], s[1 * 33]); o.y = pk2(s[2 * 33], s[3 * 33]); o.z = pk2(s[4 * 33], s[5 * 33]); o.w = pk2(s[6 * 33], s[7 * 33]);
        *(u32x4*)(WT + (size_t)prow(row_off + n0 + n) * K + k0 + 8 * c) = o; }
    asm volatile("s_waitcnt lgkmcnt(0)" ::: "memory");
}
__device__ __forceinline__ void rms_row(const float* xrow, const float* g, bf16_t* orow, int lane) {
    const f32x4* xr = (const f32x4*)xrow + lane; f32x4 v[4]; float s = 0.f;
#pragma unroll
    for (int j = 0; j < 4; ++j) { v[j] = xr[64 * j]; s += (v[j].x * v[j].x + v[j].y * v[j].y) + (v[j].z * v[j].z + v[j].w * v[j].w); }
    const float rs = __builtin_amdgcn_rsqf(wave_sum(s) * (1.f / 1024.f) + EPS);
    u32x2* o8 = (u32x2*)orow + lane;
#pragma unroll
    for (int j = 0; j < 4; ++j) { const f32x4 gg = ((const f32x4*)g)[64 * j + lane]; const f32x4 t = v[j] * rs * gg; u32x2 p; p.x = pk2(t.x, t.y); p.y = pk2(t.z, t.w); o8[64 * j] = p; }
}
__device__ __forceinline__ void rms_row2(const float* xa, const float* xb, const float* g, bf16_t* oa, bf16_t* ob, int lane) {
    const f32x4* pa = (const f32x4*)xa + lane; const f32x4* pb = (const f32x4*)xb + lane; f32x4 va[4], vb[4]; float sa = 0.f, sb = 0.f;
#pragma unroll
    for (int j = 0; j < 4; ++j) { va[j] = pa[64 * j]; vb[j] = pb[64 * j]; }
#pragma unroll
    for (int j = 0; j < 4; ++j) { sa += (va[j].x * va[j].x + va[j].y * va[j].y) + (va[j].z * va[j].z + va[j].w * va[j].w); sb += (vb[j].x * vb[j].x + vb[j].y * vb[j].y) + (vb[j].z * vb[j].z + vb[j].w * vb[j].w); }
    const float ra = __builtin_amdgcn_rsqf(wave_sum(sa) * (1.f / 1024.f) + EPS), rb = __builtin_amdgcn_rsqf(wave_sum(sb) * (1.f / 1024.f) + EPS);
    u32x2* qa = (u32x2*)oa + lane; u32x2* qb = (u32x2*)ob + lane;
#pragma unroll
    for (int j = 0; j < 4; ++j) { const f32x4 gg = ((const f32x4*)g)[64 * j + lane]; const f32x4 ta = va[j] * ra * gg, tb = vb[j] * rb * gg;
        u32x2 p; p.x = pk2(ta.x, ta.y); p.y = pk2(ta.z, ta.w); qa[64 * j] = p; u32x2 q; q.x = pk2(tb.x, tb.y); q.y = pk2(tb.z, tb.w); qb[64 * j] = q; }
}
__device__ __forceinline__ void cvt_row(const float* src, bf16_t* dst, int n4, int lane) {
    u32x2* o8 = (u32x2*)dst + lane;
    for (int j = 0; j < n4; ++j) { u32x2 p; p.x = 0u; p.y = 0u; if (src) { const f32x4 t = ((const f32x4*)src)[64 * j + lane]; p.x = pk2(t.x, t.y); p.y = pk2(t.z, t.w); } o8[64 * j] = p; }
}


__device__ __forceinline__ void skinny_splitk(const bf16_t* A, const bf16_t* Wt, const int K, float* C, const int item) {
    int tid = threadIdx.x; asm volatile("" : "+v"(tid));
    const int lane = tid & 63, w = __builtin_amdgcn_readfirstlane(tid >> 6), q32 = lane & 31, hi = lane >> 5;
    const int cblk = item & 31, ksl = item >> 5, klen = K >> 3, k0 = ksl * klen, col = 32 * cblk + q32;
    const bf16_t* ap = A + (size_t)(32 * w + q32) * K + k0 + 8 * hi;
    const bf16_t* bp = Wt + (size_t)prow(col) * K + k0 + 8 * hi;
    f32x16 acc = f32x16{};
#pragma unroll 8
    for (int kk = 0; kk < klen; kk += 16) acc = MFMA32(*(const bf16x8*)(ap + kk), *(const bf16x8*)(bp + kk), acc);
    float* cp = C + (size_t)(32 * w + 4 * hi) * 1024 + col;
#pragma unroll
    for (int r = 0; r < 16; ++r) unsafeAtomicAdd(cp + (size_t)((r & 3) + 8 * (r >> 2)) * 1024, acc[r]);
}
__device__ __forceinline__ void copy_row(const float* src, float* dst, int lane) {
#pragma unroll
    for (int j = 0; j < 4; ++j) ((f32x4*)dst)[64 * j + lane] = ((const f32x4*)src)[64 * j + lane];
}

#define GSYNC() grid.sync()
#define BW_XCNT(j) (1024 + 64 * (j))
#define BW_XSUB(j) (2048 + 64 * (j))
#define BW_XGEN(j) (3072 + 64 * (j))
#define BW_TOP 4096
#define BW_TOPGEN 4160
#define BW_LD(i) __hip_atomic_load(barw + (i), __ATOMIC_RELAXED, __HIP_MEMORY_SCOPE_AGENT)
#define FSYNC() do { asm volatile("s_waitcnt vmcnt(0) lgkmcnt(0)" ::: "memory"); __syncthreads(); ++bar_epoch; \
    if (TIDX == 0) { const unsigned nloc_ = bst[0], nx_ = bst[1], xc_ = bst[2]; \
        const unsigned old_ = __hip_atomic_fetch_add(barw + BW_XSUB(xc_), 1u, __ATOMIC_RELAXED, __HIP_MEMORY_SCOPE_AGENT); \
        if (old_ + 1u == bar_epoch * nloc_) { \
            __builtin_amdgcn_fence(__ATOMIC_RELEASE, "agent"); asm volatile("s_waitcnt vmcnt(0)" ::: "memory"); \
            const unsigned og_ = __hip_atomic_fetch_add(barw + BW_TOP, 1u, __ATOMIC_RELAXED, __HIP_MEMORY_SCOPE_AGENT); \
            if (og_ + 1u == bar_epoch * nx_) __hip_atomic_store(barw + BW_TOPGEN, bar_epoch, __ATOMIC_RELAXED, __HIP_MEMORY_SCOPE_AGENT); \
            else while (BW_LD(BW_TOPGEN) < bar_epoch) __builtin_amdgcn_s_sleep(1); \
            __builtin_amdgcn_fence(__ATOMIC_ACQUIRE, "agent"); \
            __hip_atomic_store(barw + BW_XGEN(xc_), bar_epoch, __ATOMIC_RELAXED, __HIP_MEMORY_SCOPE_AGENT); asm volatile("s_waitcnt vmcnt(0)" ::: "memory"); \
        } else { while (BW_LD(BW_XGEN(xc_)) < bar_epoch) __builtin_amdgcn_s_sleep(1); \
            __builtin_amdgcn_fence(__ATOMIC_ACQUIRE, "agent"); asm volatile("s_waitcnt vmcnt(0)" ::: "memory"); } } \
    __syncthreads(); } while (0)

#ifdef NO_ATT2
#define ATT2(...) do{}while(0)
#else
#define ATT2 attn_unit<true, false, false>
#define ATT2F attn_unit<true, true, false>
#define ATT2S attn_unit<true, false, true>
#endif
#ifdef NO_ATT1
#define ATT1(...) do{}while(0)
#else
#define ATT1 attn_unit<false, false, false>
#define ATT1S attn_unit<false, false, true>
#endif

struct Args { const float* in[25]; float* out; unsigned char* ws; };
enum { I_XP = 0, I_XS, I_CAK, I_CAV, I_CBK, I_CBV, I_N1G, I_WIN, I_QNA, I_KNA, I_QNB, I_KNB, I_LQ1, I_LK1, I_LQ2, I_LK2, I_SUBG, I_RELB, I_WBRA, I_WBRB, I_WGATE, I_WOUT, I_N2G, I_WFF1, I_WFF2 };

__global__ void __launch_bounds__(512, 2) fwd_kernel(Args a) {
    extern __shared__ __attribute__((aligned(16))) unsigned char lds_raw[];
    LAS unsigned char* lds = (LAS unsigned char*)lds_raw;
    cg::grid_group grid = cg::this_grid();
    const int wave = __builtin_amdgcn_readfirstlane((int)threadIdx.x >> 6);
    const int G = gridDim.x, bx = blockIdx.x;
#define TIDX ((int)threadIdx.x)
#define LANEX ((int)threadIdx.x & 63)
    const int vcu = (G % 8 == 0) ? (bx % 8) * (G / 8) + bx / 8 : bx;
    const int gw = bx * 8 + wave, NGW = G * 8;
    unsigned char* ws = a.ws; float* out = a.out;
    bf16_t* XN = (bf16_t*)(ws + WS_XN); float* X1 = (float*)(ws + WS_X1);
    bf16_t* QA = (bf16_t*)(ws + WS_QA); bf16_t* QB = (bf16_t*)(ws + WS_QB);
    bf16_t* KA = (bf16_t*)(ws + WS_KA); bf16_t* VA = (bf16_t*)(ws + WS_VA); bf16_t* KB = (bf16_t*)(ws + WS_KB); bf16_t* VB = (bf16_t*)(ws + WS_VB);
    bf16_t* GATE = (bf16_t*)(ws + WS_GATE); bf16_t* UB = (bf16_t*)(ws + WS_U);
    unsigned* barw = (unsigned*)(ws + WS_CTR); unsigned bar_epoch = 0;
    volatile LAS unsigned* bst = (volatile LAS unsigned*)(lds + 143 * 1024);
    if (TIDX == 0) { const unsigned xc = (unsigned)__builtin_amdgcn_s_getreg((3 << 11) | 20) & 0xFu; bst[2] = xc; __hip_atomic_fetch_add(barw + BW_XCNT(xc), 1u, __ATOMIC_RELAXED, __HIP_MEMORY_SCOPE_AGENT); }
    float* Y = out + O_Y;

    if (bx == 0 && TIDX < 64) ((unsigned*)(ws + WS_CTR))[TIDX] = 0u;
    {
        LAS float* scr = (LAS float*)(lds + wave * 16384);
        int ln0 = LANEX; asm volatile("" : "+v"(ln0));
        constexpr int I_IN = 16 * 144, I_GT = 16 * 64, I_A = 16 * 32, I_B = 8 * 32, I_O = 16 * 32, I_1 = 16 * 128, I_2 = 64 * 32, I_L = I_IN + I_GT + I_A + I_B + I_O + I_1 + I_2;
        for (int it = gw; it < 2 * I_L; it += NGW) {
            const int l = it / I_L; int r = it % I_L; unsigned char* wl = ws + WS_W + (size_t)l * WL_SIZE;
            if (r < I_IN) { transpose_item(a.in[I_WIN] + (size_t)l * 1024 * NIN, 1024, NIN, (bf16_t*)(wl + WL_W1), 0, scr, r, ln0); continue; } r -= I_IN;
            if (r < I_GT) { transpose_item(a.in[I_WGATE] + (size_t)l * 1024 * 2048, 1024, 2048, (bf16_t*)(wl + WL_W1), NIN, scr, r, ln0); continue; } r -= I_GT;
            if (r < I_A)  { transpose_item(a.in[I_WBRA] + (size_t)l * 1024 * 1024, 1024, 1024, (bf16_t*)(wl + WL_BRA), 0, scr, r, ln0); continue; } r -= I_A;
            if (r < I_B)  { transpose_item(a.in[I_WBRB] + (size_t)l * 512 * 1024, 512, 1024, (bf16_t*)(wl + WL_BRB), 0, scr, r, ln0); continue; } r -= I_B;
            if (r < I_O)  { transpose_item(a.in[I_WOUT] + (size_t)l * 1024 * 1024, 1024, 1024, (bf16_t*)(wl + WL_OUT), 0, scr, r, ln0); continue; } r -= I_O;
            if (r < I_1)  { transpose_item(a.in[I_WFF1] + (size_t)l * 1024 * DFF, 1024, DFF, (bf16_t*)(wl + WL_FF1), 0, scr, r, ln0); continue; } r -= I_1;
            transpose_item(a.in[I_WFF2] + (size_t)l * DFF * 1024, DFF, 1024, (bf16_t*)(wl + WL_FF2), 0, scr, r, ln0);
        }
    }

    for (int l = 0; l < 2; ++l) {
        int gwo = gw; asm volatile("" : "+s"(gwo));
        int ln = LANEX; asm volatile("" : "+v"(ln));
        for (int m = gwo; m < MT; m += 2 * NGW) {
            const int m2 = (m + NGW < MT) ? m + NGW : m;
            const float* xa = (l == 0) ? (m < MP ? a.in[I_XP] + (size_t)m * 1024 : a.in[I_XS] + (size_t)(m - MP) * 1024) : Y + (size_t)m * 1024;
            const float* xb = (l == 0) ? (m2 < MP ? a.in[I_XP] + (size_t)m2 * 1024 : a.in[I_XS] + (size_t)(m2 - MP) * 1024) : Y + (size_t)m2 * 1024;
            rms_row2(xa, xb, a.in[I_N1G] + l * 1024, XN + (size_t)m * 1024, XN + (size_t)m2 * 1024, ln);
        }
        for (int m = gwo; m < MS; m += NGW) copy_row((l == 0) ? a.in[I_XS] + (size_t)m * 1024 : Y + (size_t)(MP + m) * 1024, X1 + (size_t)(MP + m) * 1024, ln);
        if (l == 0) { GSYNC();
            if (TIDX == 0) { unsigned mine = 0u, cnt = 0u; const unsigned xc = bst[2];
                for (unsigned jx = 0; jx < 16; ++jx) { const unsigned c = BW_LD(BW_XCNT(jx)); cnt += (c > 0u) ? 1u : 0u; mine = (jx == xc) ? c : mine; }
                bst[0] = mine; bst[1] = cnt; } }
        else FSYNC();

        unsigned char* wl = ws + WS_W + (size_t)l * WL_SIZE;
        {
            pg8::Gemm g{XN, (const bf16_t*)(wl + WL_W1), MT, NG1, 1024}; pg8::StaticOrder S; S.init(MT, NG1, G, bx);
            EpiG1 E{QA, KA, VA, QB, KB, VB, GATE, out, l, a.in[I_QNA] + l * 64, a.in[I_KNA] + l * 64, a.in[I_QNB] + l * 64, a.in[I_KNB] + l * 64};
            pg8::gemm_phase<EpiG1, pg8::StaticOrder, true, true>(lds, g, S, E);
        }
        FSYNC();

        {
            float lam;
            { int la = LANEX; asm volatile("" : "+v"(la)); const float p1 = wave_sum(a.in[I_LQ1][l * 64 + la] * a.in[I_LK1][l * 64 + la]), p2 = wave_sum(a.in[I_LQ2][l * 64 + la] * a.in[I_LK2][l * 64 + la]);
              const float lam_init = 0.8f - 0.6f * __expf(-0.3f * (float)l); lam = __expf(p1) - __expf(p2) + lam_init; }
            const float osc = 1.f - (0.8f - 0.6f * __expf(-0.3f * (float)l));
            const float* subg = a.in[I_SUBG] + l * 128;
            LAS float* tab = (LAS float*)(lds + 140 * 1024);
            int tda = TIDX; asm volatile("" : "+v"(tda));
            const float* relb = a.in[I_RELB] + (size_t)l * 8 * 257;
            float smax;
            { int la = LANEX; asm volatile("" : "+v"(la)); smax = 8.08f * wave_max(__builtin_fabsf(a.in[I_QNA][l * 64 + la])) * wave_max(__builtin_fabsf(a.in[I_KNA][l * 64 + la])); }
            smax = __builtin_bit_cast(float, __builtin_amdgcn_readfirstlane(__builtin_bit_cast(int, smax)));
            lam = __builtin_bit_cast(float, __builtin_amdgcn_readfirstlane(__builtin_bit_cast(int, lam)));
            const float mref0 = -smax * LOG2E;
            unsigned* ctr = (unsigned*)(ws + WS_CTR) + l * 16;
            LAS int* nxt = (LAS int*)(lds + 142 * 1024);
            int qx = (int)(__builtin_amdgcn_s_getreg((3 << 11) | 20) & 7u), tried = 0;
#define QND(x) ((((x) & 3) == 0) ? 192 : ((((x) & 3) == 1) ? 320 : ((((x) & 3) == 2) ? 128 : 384)))
            int vpre = 0;
            if (tda == 0) vpre = (int)atomicAdd(ctr + qx, 1u);
            for (;;) {
                if (tda == 0) {
                    int v = vpre;
                    while (!(v < 32 + QND(qx) + 128 || tried == 7)) { qx = (qx + 1) & 7; ++tried; v = (int)atomicAdd(ctr + qx, 1u); }
                    nxt[0] = v; nxt[1] = qx;
                }
                __syncthreads();
                int idx = nxt[0]; const int x = nxt[1];
                __syncthreads();
                if (idx >= 32 + QND(x) + 128) break;
                if (tda == 0) vpre = (int)atomicAdd(ctr + qx, 1u);
                {
                    const int n1 = ((x & 3) < 2) ? 32 : (((x & 3) == 2) ? 100 : 128);
                    if (idx < n1) idx += 32; else if (idx < n1 + 32) idx -= n1;
                }
                if (idx < 16) {
                    const int id = x * 16 + idx, sq = id >> 3, h = id & 7;
                    AUnit u{MP + 16 * sq, MP + sq * SA_LEN, 2048, 16, 2064, h, 0, 32};
                    ATT2S(lds, QA, KA, VA, QA, u, a.in[I_CAK] + (size_t)(l * 16 + sq) * 2048 * 1024, a.in[I_CAV] + (size_t)(l * 16 + sq) * 2048 * 1024, out + O_AK_S + (size_t)l * 262144 + (size_t)sq * 16 * 1024, out + O_AV_S + (size_t)l * 262144 + (size_t)sq * 16 * 1024,
                          1 << 20, exp2f(-(float)(h + 1)) * LOG2E, lam, subg, osc, tab, mref0);
                } else if (idx < 32) {
                    const int id = x * 16 + idx - 16, sq = id >> 3, h = id & 7;
                    if (tda < 257) tab[tda] = relb[h * 257 + tda] * LOG2E;
                    AUnit u{MP + 16 * sq, MP + sq * SB_LEN, 512, 16, 528, h, 0, 8};
                    ATT1S(lds, QB, KB, VB, QB, u, a.in[I_CBK] + (size_t)(l * 16 + sq) * 512 * 512, a.in[I_CBV] + (size_t)(l * 16 + sq) * 512 * 512, out + O_BK_S + (size_t)l * 131072 + (size_t)sq * 16 * 512, out + O_BV_S + (size_t)l * 131072 + (size_t)sq * 16 * 512,
                          8, 0.f, 0.f, nullptr, 1.f, tab, mref0);
                } else if (idx < 32 + QND(x)) {
                    idx -= 32; const int b = x >> 2, t = x & 3; int h, qb;
                    if (t == 0)      { if (idx < 64) { h = 7; qb = 127 - 2 * idx; } else { h = 3; qb = 127 - (idx - 64); } }
                    else if (t == 1) { if (idx < 64) { h = 7; qb = 126 - 2 * idx; } else if (idx < 192) { h = 2; qb = 127 - (idx - 64); } else { h = 0; qb = 127 - (idx - 192); } }
                    else if (t == 2) { h = 6; qb = 127 - idx; }
                    else             { const int which = idx >> 7; h = (which == 0) ? 5 : ((which == 1) ? 4 : 1); qb = 127 - (idx & 127); }
                    const float slope = exp2f(-(float)(h + 1));
                    const float dmax = (2.f * smax + 17.33f - __logf(1.f - __expf(-slope))) / slope;
                    const int win = (dmax > 1.0e6f) ? (1 << 20) : (int)((dmax + 63.f) * (1.f / 64.f)) + 1;
                    AUnit u{b * SEQ + 128 * qb, b * SEQ, 128 * qb, 128, 1 << 30, h, max(0, 2 * qb - win), 2 * qb + 1};
                    if (smax * LOG2E < 40.f) ATT2F(lds, QA, KA, VA, QA, u, nullptr, nullptr, nullptr, nullptr, win, slope * LOG2E, lam, subg, osc, tab, smax * LOG2E);
                    else ATT2(lds, QA, KA, VA, QA, u, nullptr, nullptr, nullptr, nullptr, win, slope * LOG2E, lam, subg, osc, tab, mref0);
                } else {
                    idx -= 32 + QND(x); const int id = x * 128 + idx, bh = id >> 6, qb = id & 63, b = bh >> 3, h = bh & 7;
                    if (tda < 257) tab[tda] = relb[h * 257 + tda] * LOG2E;
                    const int c0 = 4 * qb;
                    AUnit u{b * SEQ + 256 * qb, b * SEQ, 256 * qb, 256, 1 << 30, h, max(0, c0 - 8), c0 + 3};
                    ATT1(lds, QB, KB, VB, QB, u, nullptr, nullptr, nullptr, nullptr, 8, 0.f, 0.f, nullptr, 1.f, tab, mref0);
                }
            }
#undef QND
        }
        FSYNC();

        {
            pg8::Gemm g{QB, (const bf16_t*)(wl + WL_BRB), MT, 1024, 512}; pg8::StaticOrder S; S.init(MT, 1024, G, bx);
            EpiGate<false> E{XN, GATE + 1024};
            pg8::gemm_phase<EpiGate<false>, pg8::StaticOrder, true, true>(lds, g, S, E);
        }
        {
            pg8::Gemm g{QA, (const bf16_t*)(wl + WL_BRA), MT, 1024, 1024}; pg8::StaticOrder S; S.init(MT, 1024, G, bx);
            EpiGate<true> E{XN, GATE};
            pg8::gemm_phase<EpiGate<true>, pg8::StaticOrder, true, true>(lds, g, S, E);
        }
        FSYNC();
        {
            pg8::Gemm g{XN, (const bf16_t*)(wl + WL_OUT), MP, 1024, 1024}; pg8::StaticOrder S; S.init(MP, 1024, G, bx);
            EpiResid E{(l == 0) ? a.in[I_XP] : Y, (l == 0) ? a.in[I_XS] : Y + (size_t)MP * 1024, X1};
            pg8::gemm_phase<EpiResid, pg8::StaticOrder, true, true>(lds, g, S, E);
            int bxo = bx; asm volatile("" : "+s"(bxo));
            for (int it = bxo; it < 256; it += G) skinny_splitk(XN + (size_t)MP * 1024, (const bf16_t*)(wl + WL_OUT), 1024, X1 + (size_t)MP * 1024, it);
        }
        FSYNC();
        { int ln2 = LANEX; asm volatile("" : "+v"(ln2));
          int gwo2 = gw; asm volatile("" : "+s"(gwo2));
          for (int m = gwo2; m < MT; m += 2 * NGW) { const int m2 = (m + NGW < MT) ? m + NGW : m;
              rms_row2(X1 + (size_t)m * 1024, X1 + (size_t)m2 * 1024, a.in[I_N2G] + l * 1024, XN + (size_t)m * 1024, XN + (size_t)m2 * 1024, ln2); }
          for (int m = gwo2; m < MS; m += NGW) copy_row(X1 + (size_t)(MP + m) * 1024, Y + (size_t)(MP + m) * 1024, ln2); }
        FSYNC();
        {
            pg8::Gemm g{XN, (const bf16_t*)(wl + WL_FF1), MT, DFF, 1024}; pg8::StaticOrder S; S.init(MT, DFF, G, bx);
            EpiRelu2 E{UB};
            pg8::gemm_phase<EpiRelu2, pg8::StaticOrder, true, true>(lds, g, S, E);
        }
        FSYNC();
        {
            pg8::Gemm g{UB, (const bf16_t*)(wl + WL_FF2), MP, 1024, DFF}; pg8::StaticOrder S; S.init(MP, 1024, G, bx);
            EpiResid E{X1, X1 + (size_t)MP * 1024, Y};
            pg8::gemm_phase<EpiResid, pg8::StaticOrder, true, true>(lds, g, S, E);
            int bxo = bx; asm volatile("" : "+s"(bxo));
            for (int it = bxo; it < 256; it += G) skinny_splitk(UB + (size_t)MP * DFF, (const bf16_t*)(wl + WL_FF2), DFF, Y + (size_t)MP * 1024, it);
        }
        if (l == 0) FSYNC();
    }
}

extern "C" void kernel_launch(void* const* d_in, const int* in_sizes, int n_in, void* d_out, int out_size, void* d_ws, size_t ws_size, hipStream_t stream) {
    static int grid = 0;
    if (grid == 0) {
        if (n_in != 25 || ws_size < WS_END + 32768) { fprintf(stderr, "kernel_launch: unexpected n_in %d / ws %zu\n", n_in, ws_size); grid = -1; return; }
        int dev = 0, cus = 0, per_cu = 0;
        hipGetDevice(&dev); hipDeviceGetAttribute(&cus, hipDeviceAttributeMultiprocessorCount, dev);
        if (hipFuncSetAttribute((const void*)fwd_kernel, hipFuncAttributeMaxDynamicSharedMemorySize, LDS_BYTES) != hipSuccess) { fprintf(stderr, "kernel_launch: hipFuncSetAttribute failed\n"); }
        if (hipOccupancyMaxActiveBlocksPerMultiprocessor(&per_cu, (const void*)fwd_kernel, 512, LDS_BYTES) != hipSuccess || per_cu < 1) { fprintf(stderr, "kernel_launch: occupancy query says %d\n", per_cu); per_cu = 1; }
        (void)hipGetLastError();
        grid = cus * 1;
    }
    if (grid < 0) return;
    if (hipMemsetAsync((char*)d_ws + WS_CTR, 0, 32768, stream) != hipSuccess) { fprintf(stderr, "kernel_launch: memset of the control words failed\n"); return; }
    Args a{};
    for (int i = 0; i < 25; ++i) a.in[i] = (const float*)d_in[i];
    a.out = (float*)d_out; a.ws = (unsigned char*)d_ws;
    void* args[] = {&a};
    hipError_t e = hipLaunchCooperativeKernel((const void*)fwd_kernel, dim3(grid), dim3(512), args, LDS_BYTES, stream);
    if (e != hipSuccess) fprintf(stderr, "cooperative launch failed: %s (grid %d)\n", hipGetErrorString(e), grid);
}
```

```cpp
#include <hip/hip_runtime.h>
#include <hip/hip_cooperative_groups.h>
#include <cstdio>
#include <cstdint>
namespace cg = cooperative_groups;

#define LAS __attribute__((address_space(3)))
typedef unsigned short bf16_t;
typedef short bf16x8 __attribute__((ext_vector_type(8)));
typedef short s16x4 __attribute__((ext_vector_type(4)));
typedef float f32x4 __attribute__((ext_vector_type(4)));
typedef float f32x16 __attribute__((ext_vector_type(16)));
typedef unsigned u32x4 __attribute__((ext_vector_type(4)));
typedef unsigned u32x2 __attribute__((ext_vector_type(2)));

constexpr int DM = 1024, SEQ = 16384, MP = 2 * SEQ, MS = 256, MT = MP + MS;
constexpr int NIN = 4608, NG1 = 6656, DFF = 4096;
constexpr int SA_LEN = 2112, SB_LEN = 576;
constexpr int KA_ROWS = MP + 16 * SA_LEN, KB_ROWS = MP + 16 * SB_LEN;
constexpr float EPS = 1e-6f, LOG2E = 1.4426950408889634f, C2 = 0.125f * LOG2E;
constexpr size_t O_Y = 0, O_AK_P = 33816576, O_AV_P = 100925440, O_BK_P = 168034304, O_BV_P = 169082880,
                 O_AK_S = 170131456, O_AV_S = 170655744, O_BK_S = 171180032, O_BV_S = 171442176;
constexpr size_t MiB = 1u << 20;
constexpr size_t WL_W1 = 0, WL_BRA = 13631488, WL_BRB = WL_BRA + 2097152, WL_OUT = WL_BRB + 1048576, WL_FF1 = WL_OUT + 2097152, WL_FF2 = WL_FF1 + 8388608, WL_SIZE = 34 * MiB;
constexpr size_t WS_W = 0, WS_XN = 68 * MiB, WS_X1 = WS_XN + 65 * MiB, WS_QA = WS_X1 + 129 * MiB, WS_QB = WS_QA + 65 * MiB, WS_KA = WS_QB + 33 * MiB,
                 WS_VA = WS_KA + 130 * MiB, WS_KB = WS_VA + 130 * MiB, WS_VB = WS_KB + 41 * MiB, WS_GATE = WS_VB + 41 * MiB, WS_END = WS_GATE + 129 * MiB;
constexpr size_t WS_CTR = WS_END;
constexpr size_t WS_U = WS_KA;
static_assert((size_t)KA_ROWS * 1024 * 2 <= 130 * MiB && (size_t)MT * 4096 * 2 <= 260 * MiB && (size_t)KB_ROWS * 512 * 2 <= 41 * MiB && WS_END <= 1024 * MiB, "ws map");

constexpr int GEMM_LDS = 131072, LDS_BYTES = 147456;

__device__ __forceinline__ unsigned cvt_pk_bf16(float lo, float hi) { unsigned r; asm volatile("v_cvt_pk_bf16_f32 %0, %1, %2" : "=v"(r) : "v"(lo), "v"(hi)); return r; }
__device__ __forceinline__ unsigned f2bf(float f) { unsigned u = __builtin_bit_cast(unsigned, f); return (u + 0x7fffu + ((u >> 16) & 1u)) >> 16; }
__device__ __forceinline__ unsigned pk2(float lo, float hi) { return f2bf(lo) | (f2bf(hi) << 16); }
__device__ __forceinline__ float bf2f(unsigned short b) { return __builtin_bit_cast(float, (unsigned)b << 16); }


__device__ __forceinline__ void swap32(float& a, float& b) { asm volatile("s_nop 1\n\tv_permlane32_swap_b32 %0, %1\n\ts_nop 1" : "+v"(a), "+v"(b)); }
__device__ __forceinline__ void swap16(float& a, float& b) { asm volatile("s_nop 1\n\tv_permlane16_swap_b32 %0, %1\n\ts_nop 1" : "+v"(a), "+v"(b)); }
__device__ __forceinline__ float x32_sum(float v) { float a = v, b = v; swap32(a, b); return a + b; }
__device__ __forceinline__ float x32_max(float v) { float a = v, b = v; swap32(a, b); return fmaxf(a, b); }
__device__ __forceinline__ float x16_sum(float v) { float a = v, b = v; swap16(a, b); return a + b; }
__device__ __forceinline__ float dpp_add(float v, const int ctrl_sel) {
    int t;
    if (ctrl_sel == 0) t = __builtin_amdgcn_mov_dpp(__builtin_bit_cast(int, v), 0xB1, 0xf, 0xf, true);
    else if (ctrl_sel == 1) t = __builtin_amdgcn_mov_dpp(__builtin_bit_cast(int, v), 0x4E, 0xf, 0xf, true);
    else if (ctrl_sel == 2) t = __builtin_amdgcn_mov_dpp(__builtin_bit_cast(int, v), 0x141, 0xf, 0xf, true);
    else t = __builtin_amdgcn_mov_dpp(__builtin_bit_cast(int, v), 0x140, 0xf, 0xf, true);
    return v + __builtin_bit_cast(float, t);
}
__device__ __forceinline__ float dpp_max(float v, const int ctrl_sel) {
    int t;
    if (ctrl_sel == 0) t = __builtin_amdgcn_mov_dpp(__builtin_bit_cast(int, v), 0xB1, 0xf, 0xf, true);
    else if (ctrl_sel == 1) t = __builtin_amdgcn_mov_dpp(__builtin_bit_cast(int, v), 0x4E, 0xf, 0xf, true);
    else if (ctrl_sel == 2) t = __builtin_amdgcn_mov_dpp(__builtin_bit_cast(int, v), 0x141, 0xf, 0xf, true);
    else t = __builtin_amdgcn_mov_dpp(__builtin_bit_cast(int, v), 0x140, 0xf, 0xf, true);
    return fmaxf(v, __builtin_bit_cast(float, t));
}
__device__ __forceinline__ float wave_max(float v) { v = dpp_max(v, 0); v = dpp_max(v, 1); v = dpp_max(v, 2); v = dpp_max(v, 3); { float a = v, b = v; swap16(a, b); v = fmaxf(a, b); } return x32_max(v); }
__device__ __forceinline__ float wave_sum(float v) { v = dpp_add(v, 0); v = dpp_add(v, 1); v = dpp_add(v, 2); v = dpp_add(v, 3); v = x16_sum(v); return x32_sum(v); }

namespace pg8 {
#define PG8_LAS __attribute__((address_space(3)))
constexpr int BM = 256, BK = 64, HALF = 128, HTB = HALF * BK * 2, STAGE_BYTES = 8 * HTB, NXCD = 8, WGM = 8;
__host__ __device__ __forceinline__ int lds_byte(int r, int c) { const int st = (r >> 4) * 2 + (c >> 5), rr = r & 15, cc = c & 31, ob = rr * 64 + cc * 2; return st * 1024 + (ob ^ (((ob >> 9) & 1) << 5)); }
__host__ __device__ __forceinline__ void stage_rc(int b, int& R, int& C) { const int st = b / 1024, sb = b % 1024, swz = sb ^ (((sb >> 9) & 1) << 5); R = (st >> 1) * 16 + swz / 64; C = (st & 1) * 32 + (swz % 64) / 2; }
__host__ __device__ __forceinline__ int perm32(int rho) { const int n = rho >> 4, i = rho & 15; return 8 * (i >> 2) + 4 * n + (i & 3); }
struct Unit { int pm, pn; };
struct Gemm { const bf16_t* A; const bf16_t* Bt; int M, N, K; };
struct StaticOrder {
    int nM, nN, nwg, G, c;
    __host__ __device__ void init(int M, int N, int G_, int c_) { nM = M / BM; nN = N / BM; nwg = nM * nN; G = G_; c = c_; }
    __host__ __device__ bool next(int i, Unit& u) const {
        const long L = (long)i * G + c; if (L >= nwg) return false;
        int wgid = (int)L; { const int q = nwg / NXCD, r = nwg % NXCD, xcd = wgid % NXCD, off = wgid / NXCD; wgid = (xcd < r ? xcd * (q + 1) : r * (q + 1) + (xcd - r) * q) + off; }
        const int nig = WGM * nN, gid = wgid / nig, fm = gid * WGM, gsz = (nM - fm) < WGM ? (nM - fm) : WGM;
        u.pm = fm + ((wgid % nig) % gsz); u.pn = (wgid % nig) / gsz; return true;
    }
    __device__ __forceinline__ void a_ready(const Unit&) const {}
    __device__ __forceinline__ void done(const Unit&) const {}
};
template <class Epi, class Sched, bool ALIGN_EPI = false, bool SP2 = false>
__device__ __forceinline__ void gemm_phase(PG8_LAS unsigned char* lds, const Gemm g, const Sched& S, const Epi& E) {
    int tid = threadIdx.x; asm volatile("" : "+v"(tid));
    const int wid = __builtin_amdgcn_readfirstlane(tid >> 6), lane = tid & 63, wr = wid >> 2, wc = wid & 3, fr = lane & 15, fq = lane >> 4;
    const int K = g.K, nt = K / BK;
    unsigned voffA[2], voffB[2];
#pragma unroll
    for (int i = 0; i < 2; ++i) { int R, C; stage_rc(tid * 16 + i * 8192, R, C); const int Rb = Epi::PERM ? ((R & ~31) + perm32(R & 31)) : R;
        voffA[i] = (unsigned)(R * K + C) * 2u; voffB[i] = (unsigned)(Rb * K + C) * 2u; }
    const size_t kstep = (size_t)(BK * 2);
    const size_t hstep = (size_t)HALF * K * 2;
    const size_t tstep = 2 * hstep;
    const unsigned ldsw = (unsigned)wid * 1024u;
    const int aoff = lds_byte(wr * 64 + fr, fq * 8), boff = lds_byte(wc * 32 + fr, fq * 8);
#define PG8_SA(b, h) (((b) * 2 + (h)) * HTB)
#define PG8_SB(b, h) ((4 + (b) * 2 + (h)) * HTB)
#define PG8_STAGE(bufoff, gbase, voff) do { _Pragma("unroll") for (int _i = 0; _i < 2; ++_i) \
        __builtin_amdgcn_global_load_lds((const unsigned*)((const char*)(gbase) + (voff)[_i]), (PG8_LAS unsigned*)(lds + (bufoff) + ldsw + _i * 8192), 16, 0, 0); } while (0)
#define PG8_LDA(dst, b, h) do { _Pragma("unroll") for (int m = 0; m < 4; ++m) _Pragma("unroll") for (int k = 0; k < 2; ++k) dst[m][k] = *(const PG8_LAS bf16x8*)(lds + PG8_SA(b, h) + aoff + m * 2048 + k * 1024); } while (0)
#define PG8_LDB(dst, b, h) do { _Pragma("unroll") for (int n = 0; n < 2; ++n) _Pragma("unroll") for (int k = 0; k < 2; ++k) dst[n][k] = *(const PG8_LAS bf16x8*)(lds + PG8_SB(b, h) + boff + n * 2048 + k * 1024); } while (0)
#define PG8_MMA(ai, bj, At, Bt) do { __builtin_amdgcn_s_setprio(1); _Pragma("unroll") for (int m = 0; m < 4; ++m) _Pragma("unroll") for (int n = 0; n < 2; ++n) _Pragma("unroll") for (int k = 0; k < 2; ++k) \
        acc[ai][bj][m][n] = __builtin_amdgcn_mfma_f32_16x16x32_bf16(Bt[n][k], At[m][k], acc[ai][bj][m][n], 0, 0, 0); __builtin_amdgcn_s_setprio(0); } while (0)
#define PG8_WAIT_V(n) asm volatile("s_waitcnt vmcnt(" #n ")" ::: "memory")
#define PG8_WAIT_L(n) asm volatile("s_waitcnt lgkmcnt(" #n ")" ::: "memory")
#define PG8_BAR __builtin_amdgcn_s_barrier()
#define PG8_SCHED __builtin_amdgcn_sched_barrier(0)
    Unit cur, nxt; int ui = 0;
    if (!S.next(0, cur)) return;
    f32x4 acc[2][2][4][2];
#pragma unroll
    for (int a = 0; a < 2; ++a)
#pragma unroll
        for (int b = 0; b < 2; ++b)
#pragma unroll
            for (int m = 0; m < 4; ++m)
#pragma unroll
                for (int n = 0; n < 2; ++n) acc[a][b][m][n] = (f32x4){0.f, 0.f, 0.f, 0.f};
    bf16x8 At[4][2], B0[2][2], B1[2][2];
    const char* cA = (const char*)g.A + (size_t)cur.pm * tstep; const char* cB = (const char*)g.Bt + (size_t)cur.pn * tstep;
    S.a_ready(cur);
    if constexpr (SP2) {
        PG8_STAGE(PG8_SB(0, 0), cB, voffB); PG8_STAGE(PG8_SB(0, 1), cB + hstep, voffB); PG8_STAGE(PG8_SA(0, 0), cA, voffA); PG8_STAGE(PG8_SA(0, 1), cA + hstep, voffA);
        if (wr == 1) PG8_BAR;
        PG8_WAIT_V(2); PG8_BAR;
        PG8_STAGE(PG8_SB(1, 0), cB + kstep, voffB); PG8_STAGE(PG8_SA(1, 0), cA + kstep, voffA); PG8_STAGE(PG8_SB(1, 1), cB + hstep + kstep, voffB);
        PG8_WAIT_V(6); PG8_BAR;
    } else {
        PG8_STAGE(PG8_SB(0, 0), cB, voffB); PG8_STAGE(PG8_SA(0, 0), cA, voffA); PG8_STAGE(PG8_SB(0, 1), cB + hstep, voffB); PG8_STAGE(PG8_SA(0, 1), cA + hstep, voffA);
        if (wr == 1) PG8_BAR;
        PG8_WAIT_V(4); PG8_BAR;
        PG8_STAGE(PG8_SB(1, 0), cB + kstep, voffB); PG8_STAGE(PG8_SA(1, 0), cA + kstep, voffA); PG8_STAGE(PG8_SB(1, 1), cB + hstep + kstep, voffB);
        PG8_WAIT_V(6); PG8_BAR;
    }
    for (;;) {
        const bool has_next = S.next(ui + 1, nxt);
        const char* nA = has_next ? (const char*)g.A + (size_t)nxt.pm * tstep : cA; const char* nB = has_next ? (const char*)g.Bt + (size_t)nxt.pn * tstep : cB;
        for (int t = 0; t < nt; t += 2) {
            const bool last = (t == nt - 2);
            const char* a1 = cA + (size_t)(t + 1) * kstep;
            const char* a2 = last ? nA : cA + (size_t)(t + 2) * kstep; const char* b2 = last ? nB : cB + (size_t)(t + 2) * kstep;
            const char* a3 = a2 + kstep; const char* b3 = b2 + kstep;
            if (last && has_next) S.a_ready(nxt);
            if constexpr (SP2) {
            PG8_LDB(B0, 0, 0); PG8_LDB(B1, 0, 1); PG8_SCHED; PG8_LDA(At, 0, 0); PG8_STAGE(PG8_SA(1, 1), a1 + hstep, voffA);
            PG8_WAIT_V(8); PG8_WAIT_L(0); PG8_BAR; PG8_MMA(0, 0, At, B0); PG8_MMA(0, 1, At, B1); PG8_BAR; PG8_SCHED;
            PG8_LDA(At, 0, 1); PG8_STAGE(PG8_SB(0, 0), b2, voffB); PG8_STAGE(PG8_SB(0, 1), b2 + hstep, voffB); PG8_STAGE(PG8_SA(0, 0), a2, voffA);
            PG8_WAIT_V(8); PG8_WAIT_L(0); PG8_BAR; PG8_MMA(1, 0, At, B0); PG8_MMA(1, 1, At, B1); PG8_BAR; PG8_SCHED;
            PG8_LDB(B0, 1, 0); PG8_LDB(B1, 1, 1); PG8_SCHED; PG8_LDA(At, 1, 0); PG8_STAGE(PG8_SA(0, 1), a2 + hstep, voffA);
            PG8_WAIT_V(8); PG8_WAIT_L(0); PG8_BAR; PG8_MMA(0, 0, At, B0); PG8_MMA(0, 1, At, B1); PG8_BAR; PG8_SCHED;
            PG8_LDA(At, 1, 1); PG8_STAGE(PG8_SB(1, 0), b3, voffB); PG8_STAGE(PG8_SB(1, 1), b3 + hstep, voffB); PG8_STAGE(PG8_SA(1, 0), a3, voffA);
            PG8_WAIT_V(8); PG8_WAIT_L(0); PG8_BAR; PG8_MMA(1, 0, At, B0); PG8_MMA(1, 1, At, B1); PG8_BAR; PG8_SCHED;
            } else {
            PG8_LDB(B0, 0, 0); PG8_SCHED; PG8_LDA(At, 0, 0); PG8_STAGE(PG8_SA(1, 1), a1 + hstep, voffA);
            PG8_WAIT_L(8); PG8_BAR; PG8_WAIT_L(0); PG8_MMA(0, 0, At, B0); PG8_BAR; PG8_SCHED;
            PG8_LDB(B1, 0, 1); PG8_STAGE(PG8_SB(0, 0), b2, voffB);
            PG8_BAR; PG8_WAIT_L(0); PG8_MMA(0, 1, At, B1); PG8_BAR;
            PG8_LDA(At, 0, 1); PG8_STAGE(PG8_SA(0, 0), a2, voffA);
            PG8_BAR; PG8_WAIT_L(0); PG8_MMA(1, 0, At, B0); PG8_BAR; PG8_SCHED;
            PG8_STAGE(PG8_SB(0, 1), b2 + hstep, voffB);
            PG8_WAIT_V(6); PG8_BAR; PG8_MMA(1, 1, At, B1); PG8_BAR;
            PG8_LDB(B0, 1, 0); PG8_SCHED; PG8_LDA(At, 1, 0); PG8_STAGE(PG8_SA(0, 1), a2 + hstep, voffA);
            PG8_WAIT_L(8); PG8_BAR; PG8_WAIT_L(0); PG8_MMA(0, 0, At, B0); PG8_BAR; PG8_SCHED;
            PG8_LDB(B1, 1, 1); PG8_STAGE(PG8_SB(1, 0), b3, voffB);
            PG8_BAR; PG8_WAIT_L(0); PG8_MMA(0, 1, At, B1); PG8_BAR;
            PG8_LDA(At, 1, 1); PG8_STAGE(PG8_SA(1, 0), a3, voffA);
            PG8_BAR; PG8_WAIT_L(0); PG8_MMA(1, 0, At, B0); PG8_BAR; PG8_SCHED;
            PG8_STAGE(PG8_SB(1, 1), b3 + hstep, voffB);
            PG8_WAIT_V(6); PG8_BAR; PG8_MMA(1, 1, At, B1); PG8_BAR;
            }
        }
        if constexpr (ALIGN_EPI) { if (wr == 0) PG8_BAR; }
        E(acc, cur, wr, wc, fr, fq); S.done(cur);
        if (!has_next) break;
#pragma unroll
        for (int a = 0; a < 2; ++a)
#pragma unroll
            for (int b = 0; b < 2; ++b)
#pragma unroll
                for (int m = 0; m < 4; ++m)
#pragma unroll
                    for (int n = 0; n < 2; ++n) acc[a][b][m][n] = (f32x4){0.f, 0.f, 0.f, 0.f};
        cur = nxt; cA = nA; cB = nB; ++ui;
        if constexpr (ALIGN_EPI) { if (wr == 1) PG8_BAR; }
    }
    PG8_WAIT_V(0);
    if constexpr (!ALIGN_EPI) { if (wr == 0) PG8_BAR; }
    PG8_BAR;
#undef PG8_SA
#undef PG8_SB
#undef PG8_STAGE
#undef PG8_LDA
#undef PG8_LDB
#undef PG8_MMA
#undef PG8_WAIT_V
#undef PG8_WAIT_L
#undef PG8_BAR
#undef PG8_SCHED
}
}

typedef const f32x4 (&AccRef)[2][2][4][2];
__device__ __forceinline__ void st8_bf16(bf16_t* p, f32x4 a, f32x4 b) { u32x4 w; w.x = cvt_pk_bf16(a[0], a[1]); w.y = cvt_pk_bf16(a[2], a[3]); w.z = cvt_pk_bf16(b[0], b[1]); w.w = cvt_pk_bf16(b[2], b[3]); *(u32x4*)p = w; }
__device__ __forceinline__ void ld8_bf16(const bf16_t* p, f32x4& a, f32x4& b) { const u32x4 w = *(const u32x4*)p;
    a = (f32x4){__builtin_bit_cast(float, w.x << 16), __builtin_bit_cast(float, w.x & 0xffff0000u), __builtin_bit_cast(float, w.y << 16), __builtin_bit_cast(float, w.y & 0xffff0000u)};
    b = (f32x4){__builtin_bit_cast(float, w.z << 16), __builtin_bit_cast(float, w.z & 0xffff0000u), __builtin_bit_cast(float, w.w << 16), __builtin_bit_cast(float, w.w & 0xffff0000u)}; }

struct EpiG1 {
    static constexpr bool PERM = true;
    bf16_t *QA, *KA, *VA, *QB, *KB, *VB, *GATE; float* out; int layer;
    const float *qn_a, *kn_a, *qn_b, *kn_b;
    __device__ __forceinline__ void operator()(AccRef acc, const pg8::Unit& u, int wr, int wc, int fr, int fq) const {
        const int pn = u.pn, lc = pn * 256 + wc * 64 + fq * 8;
        const bool samp = (u.pm >= 128);
        int mode; const float* g = nullptr; float scale = 1.f; bf16_t* dst; int pitch, cb, rowmap; float* fo = nullptr; int fpitch = 0;
        if (pn < 4)       { mode = 0; g = qn_a; scale = C2; dst = QA; pitch = 1024; cb = lc; rowmap = 0; }
        else if (pn < 8)  { mode = 0; g = kn_a; dst = KA; pitch = 1024; cb = lc - 1024; rowmap = 1; fpitch = 1024; fo = out + (samp ? O_AK_S + (size_t)layer * 262144 : O_AK_P + (size_t)layer * 33554432); }
        else if (pn < 12) { mode = 1; dst = VA; pitch = 1024; cb = lc - 2048; rowmap = 1; fpitch = 1024; fo = out + (samp ? O_AV_S + (size_t)layer * 262144 : O_AV_P + (size_t)layer * 33554432); }
        else if (pn < 14) { mode = 0; g = qn_b; scale = C2; dst = QB; pitch = 512; cb = lc - 3072; rowmap = 0; }
        else if (pn < 16) { mode = 0; g = kn_b; dst = KB; pitch = 512; cb = lc - 3584; rowmap = 2; fpitch = 512;
                            if (samp) fo = out + O_BK_S + (size_t)layer * 131072; else if ((u.pm & 63) >= 62) fo = out + O_BK_P + (size_t)layer * 524288; }
        else if (pn < 18) { mode = 1; dst = VB; pitch = 512; cb = lc - 4096; rowmap = 2; fpitch = 512;
                            if (samp) fo = out + O_BV_S + (size_t)layer * 131072; else if ((u.pm & 63) >= 62) fo = out + O_BV_P + (size_t)layer * 524288; }
        else              { mode = 2; dst = GATE; pitch = 2048; cb = lc - 4608; rowmap = 0; }
        float one = 1.f; asm volatile("" : "+v"(one));
        f32x4 gv[2][2];
        if (mode == 0) {
#pragma unroll
            for (int bj = 0; bj < 2; ++bj)
#pragma unroll
                for (int n = 0; n < 2; ++n) gv[bj][n] = *(const f32x4*)(g + bj * 32 + fq * 8 + n * 4) * scale;
        }
#pragma unroll
        for (int ai = 0; ai < 2; ++ai)
#pragma unroll
            for (int m = 0; m < 4; ++m) {
                const int row = u.pm * 256 + ai * 128 + wr * 64 + m * 16 + fr;
                f32x4 v[2][2];
#pragma unroll
                for (int bj = 0; bj < 2; ++bj)
#pragma unroll
                    for (int n = 0; n < 2; ++n) v[bj][n] = acc[ai][bj][m][n];
                if (mode == 0) {
                    float ss = 0.f;
#pragma unroll
                    for (int bj = 0; bj < 2; ++bj)
#pragma unroll
                        for (int n = 0; n < 2; ++n) { const f32x4 x = v[bj][n]; ss += (x[0] * x[0] + x[1] * x[1]) + (x[2] * x[2] + x[3] * x[3]); }
                    ss = x16_sum(ss); ss = x32_sum(ss);
                    const float rs = __builtin_amdgcn_rsqf(ss * (1.f / 64.f) + EPS);
#pragma unroll
                    for (int bj = 0; bj < 2; ++bj)
#pragma unroll
                        for (int n = 0; n < 2; ++n) v[bj][n] = v[bj][n] * rs * gv[bj][n];
                } else if (mode == 1) {
#pragma unroll
                    for (int bj = 0; bj < 2; ++bj)
#pragma unroll
                        for (int n = 0; n < 2; ++n) v[bj][n] = v[bj][n] * one;
                } else {
#pragma unroll
                    for (int bj = 0; bj < 2; ++bj)
#pragma unroll
                        for (int n = 0; n < 2; ++n)
#pragma unroll
                            for (int i = 0; i < 4; ++i) v[bj][n][i] = __builtin_amdgcn_rcpf(1.f + __builtin_amdgcn_exp2f(-LOG2E * v[bj][n][i]));
                }
                size_t drow;
                if (rowmap == 0 || !samp) drow = (size_t)row;
                else { const int r = row - MP, s = r >> 4, t = r & 15; drow = (rowmap == 1) ? (size_t)(MP + s * SA_LEN + 2048 + t) : (size_t)(MP + s * SB_LEN + 512 + t); }
                bf16_t* dp = dst + drow * pitch + cb;
#pragma unroll
                for (int bj = 0; bj < 2; ++bj) st8_bf16(dp + bj * 32, v[bj][0], v[bj][1]);
                if (fo) {
                    size_t frow;
                    if (samp) frow = (size_t)(row - MP);
                    else if (fpitch == 1024) frow = (size_t)row;
                    else frow = (size_t)((row >> 14) * 512 + (row & 16383) - 15872);
                    float* fp = fo + frow * fpitch + cb;
#pragma unroll
                    for (int bj = 0; bj < 2; ++bj) { *(f32x4*)(fp + bj * 32) = v[bj][0]; *(f32x4*)(fp + bj * 32 + 4) = v[bj][1]; }
                }
            }
    }
};
template <bool ADD> struct EpiGate {
    static constexpr bool PERM = true;
    bf16_t* Mb; const bf16_t* gate;
    __device__ __forceinline__ void operator()(AccRef acc, const pg8::Unit& u, int wr, int wc, int fr, int fq) const {
        const int lc = u.pn * 256 + wc * 64 + fq * 8;
#pragma unroll
        for (int ai = 0; ai < 2; ++ai)
#pragma unroll
            for (int m = 0; m < 4; ++m) {
                const size_t row = (size_t)(u.pm * 256 + ai * 128 + wr * 64 + m * 16 + fr);
#pragma unroll
                for (int bj = 0; bj < 2; ++bj) {
                    f32x4 g0, g1; ld8_bf16(gate + row * 2048 + lc + bj * 32, g0, g1);
                    f32x4 v0 = acc[ai][bj][m][0] * g0, v1 = acc[ai][bj][m][1] * g1;
                    bf16_t* mp = Mb + row * 1024 + lc + bj * 32;
                    if (ADD) { f32x4 p0, p1; ld8_bf16(mp, p0, p1); v0 += p0; v1 += p1; }
                    st8_bf16(mp, v0, v1);
                }
            }
    }
};
struct EpiResid {
    static constexpr bool PERM = true;
    const float* srcP; const float* srcS; float* dst;
    __device__ __forceinline__ void operator()(AccRef acc, const pg8::Unit& u, int wr, int wc, int fr, int fq) const {
        const int lc = u.pn * 256 + wc * 64 + fq * 8;
        const float* sb = (u.pm >= 128) ? srcS - (size_t)MP * 1024 : srcP;
#pragma unroll
        for (int ai = 0; ai < 2; ++ai)
#pragma unroll
            for (int m = 0; m < 4; ++m) {
                const size_t off = (size_t)(u.pm * 256 + ai * 128 + wr * 64 + m * 16 + fr) * 1024 + lc;
#pragma unroll
                for (int bj = 0; bj < 2; ++bj)
#pragma unroll
                    for (int n = 0; n < 2; ++n) { const f32x4 s = *(const f32x4*)(sb + off + bj * 32 + n * 4); *(f32x4*)(dst + off + bj * 32 + n * 4) = s + acc[ai][bj][m][n]; }
            }
    }
};
struct EpiRelu2 {
    static constexpr bool PERM = true;
    bf16_t* U;
    __device__ __forceinline__ void operator()(AccRef acc, const pg8::Unit& u, int wr, int wc, int fr, int fq) const {
        const int lc = u.pn * 256 + wc * 64 + fq * 8;
#pragma unroll
        for (int ai = 0; ai < 2; ++ai)
#pragma unroll
            for (int m = 0; m < 4; ++m) {
                bf16_t* up = U + (size_t)(u.pm * 256 + ai * 128 + wr * 64 + m * 16 + fr) * DFF + lc;
#pragma unroll
                for (int bj = 0; bj < 2; ++bj) { f32x4 a = acc[ai][bj][m][0], b = acc[ai][bj][m][1];
#pragma unroll
                    for (int i = 0; i < 4; ++i) { const float x = fmaxf(a[i], 0.f), y = fmaxf(b[i], 0.f); a[i] = x * x; b[i] = y * y; }
                    st8_bf16(up + bj * 32, a, b); }
            }
    }
};

struct AUnit { int qrow0, kvrow0, qloc0, nq, nk, h, jlo, jhi; };
#define MFMA32(a, b, c) __builtin_amdgcn_mfma_f32_32x32x16_bf16((a), (b), (c), 0, 0, 0)
__device__ __forceinline__ s16x4 vtr(const LAS unsigned char* p) { return __builtin_bit_cast(s16x4, __builtin_amdgcn_ds_read_tr16_b64_v4i16((LAS s16x4*)p)); }

template <bool DIFF, bool FIXED, bool F32SRC>
__device__ __forceinline__ void attn_unit(LAS unsigned char* lds, const bf16_t* Q, const bf16_t* __restrict__ K, const bf16_t* __restrict__ V, bf16_t* O, const AUnit u,
                                          const float* __restrict__ kc, const float* __restrict__ vc, const float* __restrict__ kn, const float* __restrict__ vn,
                                          const int win, const float slopeL2, const float lam, const float* subln_g, const float osc, const LAS float* tab, const float mref0) {
    constexpr int HW = DIFF ? 128 : 64, PITCH = DIFF ? 1024 : 512, NDB = HW / 32, NCH = HW / 64, RB = HW * 2;
    constexpr int KBUF = 64 * RB, VBUF = 64 * RB, BUF = KBUF + VBUF;
    int tid = threadIdx.x; asm volatile("" : "+v"(tid));
    const int lane = tid & 63, w = __builtin_amdgcn_readfirstlane(tid >> 6), q32 = lane & 31, hi = lane >> 5;
    const int sub = DIFF ? (w & 1) : 0, qg = DIFF ? (w >> 1) : w;
    const bool wact = (32 * qg < u.nq);
    const int qloc = u.qloc0 + 32 * qg + q32, cq = (u.qloc0 + 32 * qg) >> 6;
    const bool qvalid = (32 * qg + q32) < u.nq;
    const int qrow = qvalid ? (u.qrow0 + 32 * qg + q32) : u.qrow0;
    bf16x8 qf[4];
#pragma unroll
    for (int ks = 0; ks < 4; ++ks) qf[ks] = *(const bf16x8*)(Q + (size_t)qrow * PITCH + u.h * HW + sub * 64 + ks * 16 + hi * 8);
    float mrun = mref0, lrun = 0.f; f32x16 o[NDB];
#pragma unroll
    for (int db = 0; db < NDB; ++db) o[db] = f32x16{};
    unsigned kgo[NCH], vgo[NCH];
#pragma unroll
    for (int i = 0; i < NCH; ++i) {
        const int piece = w * NCH + i;
        const int krow = DIFF ? (piece * 4 + (lane >> 4)) : (piece * 8 + (lane >> 3));
        const int kcp = DIFF ? (lane & 15) : (lane & 7);
        const int kch = kcp ^ (DIFF ? (krow & 15) : ((krow >> 1) & 7));
        kgo[i] = (unsigned)(krow * PITCH + kch * 8);
        const int p = piece * 64 + lane, st = p >> 5, key = 8 * (st / NDB) + ((p & 31) >> 2), dch = (st % NDB) * 4 + (p & 3);
        vgo[i] = (unsigned)(key * PITCH + dch * 8);
    }
#define ATT_DMA(j, b) do { const bf16_t* kt_ = K + (size_t)(u.kvrow0 + 64 * (j)) * PITCH + u.h * HW; const bf16_t* vt_ = V + (size_t)(u.kvrow0 + 64 * (j)) * PITCH + u.h * HW; \
        _Pragma("unroll") for (int i = 0; i < NCH; ++i) { \
            __builtin_amdgcn_global_load_lds((const unsigned*)(kt_ + kgo[i]), (LAS unsigned*)(lds + (b) * BUF + (w * NCH + i) * 1024), 16, 0, 0); \
            __builtin_amdgcn_global_load_lds((const unsigned*)(vt_ + vgo[i]), (LAS unsigned*)(lds + (b) * BUF + KBUF + (w * NCH + i) * 1024), 16, 0, 0); } } while (0)
#define ATT_WAIT_BAR(n) asm volatile("s_waitcnt vmcnt(" #n ")\n\ts_barrier" ::: "memory")
    const int vlane = (4 * hi + ((lane & 15) >> 2)) * 64 + ((lane >> 4) & 1) * 32 + (lane & 3) * 8;
    const int kswz = DIFF ? (q32 & 15) : ((q32 >> 1) & 7);
    int koff[4];
#pragma unroll
    for (int ks = 0; ks < 4; ++ks) koff[ks] = q32 * RB + (((sub * 8 + 2 * ks + hi) ^ kswz) << 4);
    int j = u.jhi, buf = 0;
    if (!F32SRC) {
    asm volatile("s_waitcnt vmcnt(0)" ::: "memory");
    ATT_DMA(j, 0);
    if (j - 1 >= u.jlo) { ATT_DMA(j - 1, 1); if (NCH == 2) ATT_WAIT_BAR(4); else ATT_WAIT_BAR(2); }
    else ATT_WAIT_BAR(0);
    }
    for (; j >= u.jlo; --j) {
        if (F32SRC) {
#pragma unroll
            for (int i = 0; i < NCH; ++i) {
                const int c = tid + 512 * i, row = c / (HW / 8), ch = c % (HW / 8);
                const size_t so = (j == u.jhi) ? (size_t)min(row, 15) * PITCH + u.h * HW + ch * 8 : (size_t)(64 * j + row) * PITCH + u.h * HW + ch * 8;
                const float* ks_ = ((j == u.jhi) ? kn : kc) + so; const float* vs_ = ((j == u.jhi) ? vn : vc) + so;
                const f32x4 k0 = __builtin_nontemporal_load((const f32x4*)ks_), k1 = __builtin_nontemporal_load((const f32x4*)ks_ + 1), v0 = __builtin_nontemporal_load((const f32x4*)vs_), v1 = __builtin_nontemporal_load((const f32x4*)vs_ + 1);
                u32x4 kw, vw; kw.x = pk2(k0.x, k0.y); kw.y = pk2(k0.z, k0.w); kw.z = pk2(k1.x, k1.y); kw.w = pk2(k1.z, k1.w); vw.x = pk2(v0.x, v0.y); vw.y = pk2(v0.z, v0.w); vw.z = pk2(v1.x, v1.y); vw.w = pk2(v1.z, v1.w);
                *(LAS u32x4*)(lds + buf * BUF + row * RB + ((ch ^ (DIFF ? (row & 15) : ((row >> 1) & 7))) << 4)) = kw;
                *(LAS u32x4*)(lds + buf * BUF + KBUF + (row >> 3) * (NDB * 512) + (ch >> 2) * 512 + (row & 7) * 64 + (ch & 3) * 16) = vw;
            }
            __syncthreads();
        } else {
        const int b2 = (buf >= 1) ? buf - 1 : 2;
        if (j - 2 >= u.jlo) ATT_DMA(j - 2, b2);
        }
        const bool comp = (wact && j <= cq && j >= cq - win);
        if (comp) {
            const LAS unsigned char* kb = lds + buf * BUF; const LAS unsigned char* vb = kb + KBUF;
            const int dqi = qloc - 64 * j - 4 * hi; const float dq = (float)dqi;
            bf16x8 kf0[2], kf1[2];
#pragma unroll
            for (int ks = 0; ks < 2; ++ks) { kf0[ks] = *(const LAS bf16x8*)(kb + koff[ks]); kf1[ks] = *(const LAS bf16x8*)(kb + koff[ks] + 32 * RB); }
            f32x16 a0, a1;
            if (DIFF) {
                if (j < cq) {
                    const float base = -slopeL2 * dq - mrun;
#pragma unroll
                    for (int r = 0; r < 16; ++r) { const float c = (float)((r & 3) + 8 * (r >> 2)); a0[r] = slopeL2 * c + base; a1[r] = slopeL2 * (c + 32.f) + base; }
                } else {
#pragma unroll
                    for (int r = 0; r < 16; ++r) { const float c = (float)((r & 3) + 8 * (r >> 2)); a0[r] = -slopeL2 * __builtin_fabsf(dq - c) - mrun; a1[r] = -slopeL2 * __builtin_fabsf(dq - (c + 32.f)) - mrun; }
                }
            } else {
                if (j <= cq - 3) {
                    const float t = tab[256] - mrun;
#pragma unroll
                    for (int r = 0; r < 16; ++r) { a0[r] = t; a1[r] = t; }
                } else {
#pragma unroll
                    for (int r = 0; r < 16; ++r) { const int c = (r & 3) + 8 * (r >> 2); int i0 = dqi - c, i1 = dqi - c - 32;
                        i0 = min(max(i0, -128), 128) + 128; i1 = min(max(i1, -128), 128) + 128; a0[r] = tab[i0] - mrun; a1[r] = tab[i1] - mrun; }
                }
            }
            if (64 * j + 64 > u.nk) {
#pragma unroll
                for (int r = 0; r < 16; ++r) { const int key = 64 * j + (r & 3) + 8 * (r >> 2) + 4 * hi; if (key >= u.nk) a0[r] = -1e30f; if (key + 32 >= u.nk) a1[r] = -1e30f; }
            }
            __builtin_amdgcn_sched_barrier(0);
#pragma unroll
            for (int ks = 0; ks < 2; ++ks) { a0 = MFMA32(kf0[ks], qf[ks], a0); a1 = MFMA32(kf1[ks], qf[ks], a1); }
            __builtin_amdgcn_sched_barrier(0);
#pragma unroll
            for (int ks = 0; ks < 2; ++ks) { kf0[ks] = *(const LAS bf16x8*)(kb + koff[ks + 2]); kf1[ks] = *(const LAS bf16x8*)(kb + koff[ks + 2] + 32 * RB); }
            __builtin_amdgcn_sched_barrier(0);
#pragma unroll
            for (int ks = 0; ks < 2; ++ks) { a0 = MFMA32(kf0[ks], qf[ks + 2], a0); a1 = MFMA32(kf1[ks], qf[ks + 2], a1); }
            __builtin_amdgcn_sched_barrier(0);
            bf16x8 vf[4];
#define ATT_VLOAD(dst, db) do { _Pragma("unroll") for (int ks = 0; ks < 4; ++ks) { \
                const s16x4 lo_ = vtr(vb + (2 * ks) * (NDB * 512) + (db) * 512 + vlane), h4_ = vtr(vb + (2 * ks + 1) * (NDB * 512) + (db) * 512 + vlane); \
                dst[ks] = (bf16x8){lo_[0], lo_[1], lo_[2], lo_[3], h4_[0], h4_[1], h4_[2], h4_[3]}; } } while (0)
            if (!FIXED) {
            float mx = fmaxf(fmaxf(a0[0], a1[0]), fmaxf(a0[1], a1[1]));
#pragma unroll
            for (int r = 2; r < 16; r += 2) mx = fmaxf(fmaxf(mx, fmaxf(a0[r], a1[r])), fmaxf(a0[r + 1], a1[r + 1]));
            mx = x32_max(mx);
            if (__any(mx > 0.f)) {
                const float dl = fmaxf(mx, 0.f), al = __builtin_amdgcn_exp2f(-dl);
                lrun *= al; mrun += dl;
#pragma unroll
                for (int r = 0; r < 16; ++r) { a0[r] -= dl; a1[r] -= dl; }
#pragma unroll
                for (int db = 0; db < NDB; ++db)
#pragma unroll
                    for (int r = 0; r < 16; ++r) o[db][r] *= al;
            }
            }
            float ls = 0.f;
#pragma unroll
            for (int r = 0; r < 16; ++r) { a0[r] = __builtin_amdgcn_exp2f(a0[r]); a1[r] = __builtin_amdgcn_exp2f(a1[r]); ls += a0[r] + a1[r]; }
            lrun += ls;
            bf16x8 pf[4];
#pragma unroll
            for (int ks = 0; ks < 4; ++ks) { u32x4 p;
#pragma unroll
                for (int e = 0; e < 4; ++e) p[e] = (ks < 2) ? cvt_pk_bf16(a0[8 * ks + 2 * e], a0[8 * ks + 2 * e + 1]) : cvt_pk_bf16(a1[8 * (ks - 2) + 2 * e], a1[8 * (ks - 2) + 2 * e + 1]);
                pf[ks] = __builtin_bit_cast(bf16x8, p); }
#pragma unroll
            for (int db = 0; db < NDB; ++db) {
                ATT_VLOAD(vf, db);
                __builtin_amdgcn_sched_barrier(0);
#pragma unroll
                for (int ks = 0; ks < 4; ++ks) o[db] = MFMA32(vf[ks], pf[ks], o[db]);
                __builtin_amdgcn_sched_barrier(0);
            }
#undef ATT_VLOAD
        }
        if (F32SRC) buf ^= 1;
        else {
        if (j - 2 >= u.jlo) { if (NCH == 2) ATT_WAIT_BAR(4); else ATT_WAIT_BAR(2); }
        else ATT_WAIT_BAR(0);
        buf = (buf == 2) ? 0 : buf + 1;
        }
    }
    if (F32SRC) __syncthreads();
#undef ATT_DMA
#undef ATT_WAIT_BAR
    const float lt = x32_sum(lrun);
    float sc = 1.f / lt;
    if (DIFF) {
        LAS f32x4* xch = (LAS f32x4*)lds;
        if (wact && sub == 1) {
            const float s1 = sc * lam;
#pragma unroll
            for (int db = 0; db < NDB; ++db)
#pragma unroll
                for (int r4 = 0; r4 < 4; ++r4) xch[((qg * NDB + db) * 4 + r4) * 64 + lane] = (f32x4){o[db][4 * r4], o[db][4 * r4 + 1], o[db][4 * r4 + 2], o[db][4 * r4 + 3]} * s1;
        }
        __syncthreads();
        if (wact && sub == 0) {
            float ss = 0.f;
#pragma unroll
            for (int db = 0; db < NDB; ++db)
#pragma unroll
                for (int r4 = 0; r4 < 4; ++r4) { const f32x4 p2 = xch[((qg * NDB + db) * 4 + r4) * 64 + lane];
#pragma unroll
                    for (int i = 0; i < 4; ++i) { const float v = o[db][4 * r4 + i] * sc - p2[i]; o[db][4 * r4 + i] = v; ss += v * v; } }
            ss = x32_sum(ss);
            sc = __builtin_amdgcn_rsqf(ss * (1.f / 128.f) + EPS) * osc;
        }
    }
    if (wact && sub == 0 && qvalid) {
        bf16_t* op = O + (size_t)qrow * PITCH + u.h * HW;
#pragma unroll
        for (int db = 0; db < NDB; ++db)
#pragma unroll
            for (int r4 = 0; r4 < 4; ++r4) {
                const int d = 32 * db + 8 * r4 + 4 * hi;
                f32x4 v = (f32x4){o[db][4 * r4], o[db][4 * r4 + 1], o[db][4 * r4 + 2], o[db][4 * r4 + 3]} * sc;
                if (DIFF) v = v * *(const f32x4*)(subln_g + d);
                u32x2 pk; pk.x = cvt_pk_bf16(v[0], v[1]); pk.y = cvt_pk_bf16(v[2], v[3]);
                *(u32x2*)(op + d) = pk;
            }
    }
    if (DIFF) __syncthreads();
}

__device__ __forceinline__ int prow(int R) { const int nl = R & 255; return (R & ~255) + 128 * ((nl >> 5) & 1) + 32 * (nl >> 6) + (nl & 31); }
__device__ __forceinline__ void transpose_item(const float* W, int K, int N, bf16_t* WT, int row_off, LAS float* scr, int item, int lane) {
    const int nblk = N / 32, kb = item / nblk, nb = item % nblk, k0 = 64 * kb, n0 = 32 * nb;
#pragma unroll 8
    for (int i = 0; i < 32; ++i) { const int kk = 2 * i + (lane >> 5); scr[kk * 33 + (lane & 31)] = W[(size_t)(k0 + kk) * N + n0 + (lane & 31)]; }
    asm volatile("s_waitcnt lgkmcnt(0)" ::: "memory");
    const int c = lane & 7;
#pragma unroll
    for (int j = 0; j < 4; ++j) { const int n = (lane >> 3) + 8 * j; const LAS float* s = scr + (8 * c) * 33 + n;
        u32x4 o; o.x = pk2(s[0 * 33], s[1 * 33]); o.y = pk2(s[2 * 33], s[3 * 33]); o.z = pk2(s[4 * 33], s[5 * 33]); o.w = pk2(s[6 * 33], s[7 * 33]);
        *(u32x4*)(WT + (size_t)prow(row_off + n0 + n) * K + k0 + 8 * c) = o; }
    asm volatile("s_waitcnt lgkmcnt(0)" ::: "memory");
}
__device__ __forceinline__ void rms_row(const float* xrow, const float* g, bf16_t* orow, int lane) {
    const f32x4* xr = (const f32x4*)xrow + lane; f32x4 v[4]; float s = 0.f;
#pragma unroll
    for (int j = 0; j < 4; ++j) { v[j] = xr[64 * j]; s += (v[j].x * v[j].x + v[j].y * v[j].y) + (v[j].z * v[j].z + v[j].w * v[j].w); }
    const float rs = __builtin_amdgcn_rsqf(wave_sum(s) * (1.f / 1024.f) + EPS);
    u32x2* o8 = (u32x2*)orow + lane;
#pragma unroll
    for (int j = 0; j < 4; ++j) { const f32x4 gg = ((const f32x4*)g)[64 * j + lane]; const f32x4 t = v[j] * rs * gg; u32x2 p; p.x = pk2(t.x, t.y); p.y = pk2(t.z, t.w); o8[64 * j] = p; }
}
__device__ __forceinline__ void rms_row2(const float* xa, const float* xb, const float* g, bf16_t* oa, bf16_t* ob, int lane) {
    const f32x4* pa = (const f32x4*)xa + lane; const f32x4* pb = (const f32x4*)xb + lane; f32x4 va[4], vb[4]; float sa = 0.f, sb = 0.f;
#pragma unroll
    for (int j = 0; j < 4; ++j) { va[j] = pa[64 * j]; vb[j] = pb[64 * j]; }
#pragma unroll
    for (int j = 0; j < 4; ++j) { sa += (va[j].x * va[j].x + va[j].y * va[j].y) + (va[j].z * va[j].z + va[j].w * va[j].w); sb += (vb[j].x * vb[j].x + vb[j].y * vb[j].y) + (vb[j].z * vb[j].z + vb[j].w * vb[j].w); }
    const float ra = __builtin_amdgcn_rsqf(wave_sum(sa) * (1.f / 1024.f) + EPS), rb = __builtin_amdgcn_rsqf(wave_sum(sb) * (1.f / 1024.f) + EPS);
    u32x2* qa = (u32x2*)oa + lane; u32x2* qb = (u32x2*)ob + lane;
#pragma unroll
    for (int j = 0; j < 4; ++j) { const f32x4 gg = ((const f32x4*)g)[64 * j + lane]; const f32x4 ta = va[j] * ra * gg, tb = vb[j] * rb * gg;
        u32x2 p; p.x = pk2(ta.x, ta.y); p.y = pk2(ta.z, ta.w); qa[64 * j] = p; u32x2 q; q.x = pk2(tb.x, tb.y); q.y = pk2(tb.z, tb.w); qb[64 * j] = q; }
}
__device__ __forceinline__ void cvt_row(const float* src, bf16_t* dst, int n4, int lane) {
    u32x2* o8 = (u32x2*)dst + lane;
    for (int j = 0; j < n4; ++j) { u32x2 p; p.x = 0u; p.y = 0u; if (src) { const f32x4 t = ((const f32x4*)src)[64 * j + lane]; p.x = pk2(t.x, t.y); p.y = pk2(t.z, t.w); } o8[64 * j] = p; }
}


__device__ __forceinline__ void skinny_splitk(const bf16_t* A, const bf16_t* Wt, const int K, float* C, const int item) {
    int tid = threadIdx.x; asm volatile("" : "+v"(tid));
    const int lane = tid & 63, w = __builtin_amdgcn_readfirstlane(tid >> 6), q32 = lane & 31, hi = lane >> 5;
    const int cblk = item & 31, ksl = item >> 5, klen = K >> 3, k0 = ksl * klen, col = 32 * cblk + q32;
    const bf16_t* ap = A + (size_t)(32 * w + q32) * K + k0 + 8 * hi;
    const bf16_t* bp = Wt + (size_t)prow(col) * K + k0 + 8 * hi;
    f32x16 acc = f32x16{};
#pragma unroll 8
    for (int kk = 0; kk < klen; kk += 16) acc = MFMA32(*(const bf16x8*)(ap + kk), *(const bf16x8*)(bp + kk), acc);
    float* cp = C + (size_t)(32 * w + 4 * hi) * 1024 + col;
#pragma unroll
    for (int r = 0; r < 16; ++r) unsafeAtomicAdd(cp + (size_t)((r & 3) + 8 * (r >> 2)) * 1024, acc[r]);
}
__device__ __forceinline__ void copy_row(const float* src, float* dst, int lane) {
#pragma unroll
    for (int j = 0; j < 4; ++j) ((f32x4*)dst)[64 * j + lane] = ((const f32x4*)src)[64 * j + lane];
}

#define GSYNC() grid.sync()
#define BW_XCNT(j) (1024 + 64 * (j))
#define BW_XSUB(j) (2048 + 64 * (j))
#define BW_XGEN(j) (3072 + 64 * (j))
#define BW_TOP 4096
#define BW_TOPGEN 4160
#define BW_LD(i) __hip_atomic_load(barw + (i), __ATOMIC_RELAXED, __HIP_MEMORY_SCOPE_AGENT)
#define FSYNC() do { asm volatile("s_waitcnt vmcnt(0) lgkmcnt(0)" ::: "memory"); __syncthreads(); ++bar_epoch; \
    if (TIDX == 0) { const unsigned nloc_ = bst[0], nx_ = bst[1], xc_ = bst[2]; \
        const unsigned old_ = __hip_atomic_fetch_add(barw + BW_XSUB(xc_), 1u, __ATOMIC_RELAXED, __HIP_MEMORY_SCOPE_AGENT); \
        if (old_ + 1u == bar_epoch * nloc_) { \
            __builtin_amdgcn_fence(__ATOMIC_RELEASE, "agent"); asm volatile("s_waitcnt vmcnt(0)" ::: "memory"); \
            const unsigned og_ = __hip_atomic_fetch_add(barw + BW_TOP, 1u, __ATOMIC_RELAXED, __HIP_MEMORY_SCOPE_AGENT); \
            if (og_ + 1u == bar_epoch * nx_) __hip_atomic_store(barw + BW_TOPGEN, bar_epoch, __ATOMIC_RELAXED, __HIP_MEMORY_SCOPE_AGENT); \
            else while (BW_LD(BW_TOPGEN) < bar_epoch) __builtin_amdgcn_s_sleep(1); \
            __builtin_amdgcn_fence(__ATOMIC_ACQUIRE, "agent"); \
            __hip_atomic_store(barw + BW_XGEN(xc_), bar_epoch, __ATOMIC_RELAXED, __HIP_MEMORY_SCOPE_AGENT); asm volatile("s_waitcnt vmcnt(0)" ::: "memory"); \
        } else { while (BW_LD(BW_XGEN(xc_)) < bar_epoch) __builtin_amdgcn_s_sleep(1); \
            __builtin_amdgcn_fence(__ATOMIC_ACQUIRE, "agent"); asm volatile("s_waitcnt vmcnt(0)" ::: "memory"); } } \
    __syncthreads(); } while (0)

#ifdef NO_ATT2
#define ATT2(...) do{}while(0)
#else
#define ATT2 attn_unit<true, false, false>
#define ATT2F attn_unit<true, true, false>
#define ATT2S attn_unit<true, false, true>
#endif
#ifdef NO_ATT1
#define ATT1(...) do{}while(0)
#else
#define ATT1 attn_unit<false, false, false>
#define ATT1S attn_unit<false, false, true>
#endif

struct Args { const float* in[25]; float* out; unsigned char* ws; };
enum { I_XP = 0, I_XS, I_CAK, I_CAV, I_CBK, I_CBV, I_N1G, I_WIN, I_QNA, I_KNA, I_QNB, I_KNB, I_LQ1, I_LK1, I_LQ2, I_LK2, I_SUBG, I_RELB, I_WBRA, I_WBRB, I_WGATE, I_WOUT, I_N2G, I_WFF1, I_WFF2 };

__global__ void __launch_bounds__(512, 2) fwd_kernel(Args a) {
    extern __shared__ __attribute__((aligned(16))) unsigned char lds_raw[];
    LAS unsigned char* lds = (LAS unsigned char*)lds_raw;
    cg::grid_group grid = cg::this_grid();
    const int wave = __builtin_amdgcn_readfirstlane((int)threadIdx.x >> 6);
    const int G = gridDim.x, bx = blockIdx.x;
#define TIDX ((int)threadIdx.x)
#define LANEX ((int)threadIdx.x & 63)
    const int vcu = (G % 8 == 0) ? (bx % 8) * (G / 8) + bx / 8 : bx;
    const int gw = bx * 8 + wave, NGW = G * 8;
    unsigned char* ws = a.ws; float* out = a.out;
    bf16_t* XN = (bf16_t*)(ws + WS_XN); float* X1 = (float*)(ws + WS_X1);
    bf16_t* QA = (bf16_t*)(ws + WS_QA); bf16_t* QB = (bf16_t*)(ws + WS_QB);
    bf16_t* KA = (bf16_t*)(ws + WS_KA); bf16_t* VA = (bf16_t*)(ws + WS_VA); bf16_t* KB = (bf16_t*)(ws + WS_KB); bf16_t* VB = (bf16_t*)(ws + WS_VB);
    bf16_t* GATE = (bf16_t*)(ws + WS_GATE); bf16_t* UB = (bf16_t*)(ws + WS_U);
    unsigned* barw = (unsigned*)(ws + WS_CTR); unsigned bar_epoch = 0;
    volatile LAS unsigned* bst = (volatile LAS unsigned*)(lds + 143 * 1024);
    if (TIDX == 0) { const unsigned xc = (unsigned)__builtin_amdgcn_s_getreg((3 << 11) | 20) & 0xFu; bst[2] = xc; __hip_atomic_fetch_add(barw + BW_XCNT(xc), 1u, __ATOMIC_RELAXED, __HIP_MEMORY_SCOPE_AGENT); }
    float* Y = out + O_Y;

    if (bx == 0 && TIDX < 64) ((unsigned*)(ws + WS_CTR))[TIDX] = 0u;
    {
        LAS float* scr = (LAS float*)(lds + wave * 16384);
        int ln0 = LANEX; asm volatile("" : "+v"(ln0));
        constexpr int I_IN = 16 * 144, I_GT = 16 * 64, I_A = 16 * 32, I_B = 8 * 32, I_O = 16 * 32, I_1 = 16 * 128, I_2 = 64 * 32, I_L = I_IN + I_GT + I_A + I_B + I_O + I_1 + I_2;
        for (int it = gw; it < 2 * I_L; it += NGW) {
            const int l = it / I_L; int r = it % I_L; unsigned char* wl = ws + WS_W + (size_t)l * WL_SIZE;
            if (r < I_IN) { transpose_item(a.in[I_WIN] + (size_t)l * 1024 * NIN, 1024, NIN, (bf16_t*)(wl + WL_W1), 0, scr, r, ln0); continue; } r -= I_IN;
            if (r < I_GT) { transpose_item(a.in[I_WGATE] + (size_t)l * 1024 * 2048, 1024, 2048, (bf16_t*)(wl + WL_W1), NIN, scr, r, ln0); continue; } r -= I_GT;
            if (r < I_A)  { transpose_item(a.in[I_WBRA] + (size_t)l * 1024 * 1024, 1024, 1024, (bf16_t*)(wl + WL_BRA), 0, scr, r, ln0); continue; } r -= I_A;
            if (r < I_B)  { transpose_item(a.in[I_WBRB] + (size_t)l * 512 * 1024, 512, 1024, (bf16_t*)(wl + WL_BRB), 0, scr, r, ln0); continue; } r -= I_B;
            if (r < I_O)  { transpose_item(a.in[I_WOUT] + (size_t)l * 1024 * 1024, 1024, 1024, (bf16_t*)(wl + WL_OUT), 0, scr, r, ln0); continue; } r -= I_O;
            if (r < I_1)  { transpose_item(a.in[I_WFF1] + (size_t)l * 1024 * DFF, 1024, DFF, (bf16_t*)(wl + WL_FF1), 0, scr, r, ln0); continue; } r -= I_1;
            transpose_item(a.in[I_WFF2] + (size_t)l * DFF * 1024, DFF, 1024, (bf16_t*)(wl + WL_FF2), 0, scr, r, ln0);
        }
    }

    for (int l = 0; l < 2; ++l) {
        int gwo = gw; asm volatile("" : "+s"(gwo));
        int ln = LANEX; asm volatile("" : "+v"(ln));
        for (int m = gwo; m < MT; m += 2 * NGW) {
            const int m2 = (m + NGW < MT) ? m + NGW : m;
            const float* xa = (l == 0) ? (m < MP ? a.in[I_XP] + (size_t)m * 1024 : a.in[I_XS] + (size_t)(m - MP) * 1024) : Y + (size_t)m * 1024;
            const float* xb = (l == 0) ? (m2 < MP ? a.in[I_XP] + (size_t)m2 * 1024 : a.in[I_XS] + (size_t)(m2 - MP) * 1024) : Y + (size_t)m2 * 1024;
            rms_row2(xa, xb, a.in[I_N1G] + l * 1024, XN + (size_t)m * 1024, XN + (size_t)m2 * 1024, ln);
        }
        for (int m = gwo; m < MS; m += NGW) copy_row((l == 0) ? a.in[I_XS] + (size_t)m * 1024 : Y + (size_t)(MP + m) * 1024, X1 + (size_t)(MP + m) * 1024, ln);
        if (l == 0) { GSYNC();
            if (TIDX == 0) { unsigned mine = 0u, cnt = 0u; const unsigned xc = bst[2];
                for (unsigned jx = 0; jx < 16; ++jx) { const unsigned c = BW_LD(BW_XCNT(jx)); cnt += (c > 0u) ? 1u : 0u; mine = (jx == xc) ? c : mine; }
                bst[0] = mine; bst[1] = cnt; } }
        else FSYNC();

        unsigned char* wl = ws + WS_W + (size_t)l * WL_SIZE;
        {
            pg8::Gemm g{XN, (const bf16_t*)(wl + WL_W1), MT, NG1, 1024}; pg8::StaticOrder S; S.init(MT, NG1, G, bx);
            EpiG1 E{QA, KA, VA, QB, KB, VB, GATE, out, l, a.in[I_QNA] + l * 64, a.in[I_KNA] + l * 64, a.in[I_QNB] + l * 64, a.in[I_KNB] + l * 64};
            pg8::gemm_phase<EpiG1, pg8::StaticOrder, true, true>(lds, g, S, E);
        }
        FSYNC();

        {
            float lam;
            { int la = LANEX; asm volatile("" : "+v"(la)); const float p1 = wave_sum(a.in[I_LQ1][l * 64 + la] * a.in[I_LK1][l * 64 + la]), p2 = wave_sum(a.in[I_LQ2][l * 64 + la] * a.in[I_LK2][l * 64 + la]);
              const float lam_init = 0.8f - 0.6f * __expf(-0.3f * (float)l); lam = __expf(p1) - __expf(p2) + lam_init; }
            const float osc = 1.f - (0.8f - 0.6f * __expf(-0.3f * (float)l));
            const float* subg = a.in[I_SUBG] + l * 128;
            LAS float* tab = (LAS float*)(lds + 140 * 1024);
            int tda = TIDX; asm volatile("" : "+v"(tda));
            const float* relb = a.in[I_RELB] + (size_t)l * 8 * 257;
            float smax;
            { int la = LANEX; asm volatile("" : "+v"(la)); smax = 8.08f * wave_max(__builtin_fabsf(a.in[I_QNA][l * 64 + la])) * wave_max(__builtin_fabsf(a.in[I_KNA][l * 64 + la])); }
            smax = __builtin_bit_cast(float, __builtin_amdgcn_readfirstlane(__builtin_bit_cast(int, smax)));
            lam = __builtin_bit_cast(float, __builtin_amdgcn_readfirstlane(__builtin_bit_cast(int, lam)));
            const float mref0 = -smax * LOG2E;
            unsigned* ctr = (unsigned*)(ws + WS_CTR) + l * 16;
            LAS int* nxt = (LAS int*)(lds + 142 * 1024);
            int qx = (int)(__builtin_amdgcn_s_getreg((3 << 11) | 20) & 7u), tried = 0;
#define QND(x) ((((x) & 3) == 0) ? 192 : ((((x) & 3) == 1) ? 320 : ((((x) & 3) == 2) ? 128 : 384)))
            for (;;) {
                __syncthreads();
                if (tda == 0) {
                    int v;
                    for (;;) { v = (int)atomicAdd(ctr + qx, 1u); if (v < 32 + QND(qx) + 128 || tried == 7) break; qx = (qx + 1) & 7; ++tried; }
                    nxt[0] = v; nxt[1] = qx;
                }
                __syncthreads();
                int idx = nxt[0]; const int x = nxt[1];
                if (idx >= 32 + QND(x) + 128) break;
                {
                    const int n1 = ((x & 3) < 2) ? 32 : (((x & 3) == 2) ? 100 : 128);
                    if (idx < n1) idx += 32; else if (idx < n1 + 32) idx -= n1;
                }
                if (idx < 16) {
                    const int id = x * 16 + idx, sq = id >> 3, h = id & 7;
                    AUnit u{MP + 16 * sq, MP + sq * SA_LEN, 2048, 16, 2064, h, 0, 32};
                    ATT2S(lds, QA, KA, VA, QA, u, a.in[I_CAK] + (size_t)(l * 16 + sq) * 2048 * 1024, a.in[I_CAV] + (size_t)(l * 16 + sq) * 2048 * 1024, out + O_AK_S + (size_t)l * 262144 + (size_t)sq * 16 * 1024, out + O_AV_S + (size_t)l * 262144 + (size_t)sq * 16 * 1024,
                          1 << 20, exp2f(-(float)(h + 1)) * LOG2E, lam, subg, osc, tab, mref0);
                } else if (idx < 32) {
                    const int id = x * 16 + idx - 16, sq = id >> 3, h = id & 7;
                    if (tda < 257) tab[tda] = relb[h * 257 + tda] * LOG2E;
                    AUnit u{MP + 16 * sq, MP + sq * SB_LEN, 512, 16, 528, h, 0, 8};
                    ATT1S(lds, QB, KB, VB, QB, u, a.in[I_CBK] + (size_t)(l * 16 + sq) * 512 * 512, a.in[I_CBV] + (size_t)(l * 16 + sq) * 512 * 512, out + O_BK_S + (size_t)l * 131072 + (size_t)sq * 16 * 512, out + O_BV_S + (size_t)l * 131072 + (size_t)sq * 16 * 512,
                          8, 0.f, 0.f, nullptr, 1.f, tab, mref0);
                } else if (idx < 32 + QND(x)) {
                    idx -= 32; const int b = x >> 2, t = x & 3; int h, qb;
                    if (t == 0)      { if (idx < 64) { h = 7; qb = 127 - 2 * idx; } else { h = 3; qb = 127 - (idx - 64); } }
                    else if (t == 1) { if (idx < 64) { h = 7; qb = 126 - 2 * idx; } else if (idx < 192) { h = 2; qb = 127 - (idx - 64); } else { h = 0; qb = 127 - (idx - 192); } }
                    else if (t == 2) { h = 6; qb = 127 - idx; }
                    else             { const int which = idx >> 7; h = (which == 0) ? 5 : ((which == 1) ? 4 : 1); qb = 127 - (idx & 127); }
                    const float slope = exp2f(-(float)(h + 1));
                    const float dmax = (2.f * smax + 17.33f - __logf(1.f - __expf(-slope))) / slope;
                    const int win = (dmax > 1.0e6f) ? (1 << 20) : (int)((dmax + 63.f) * (1.f / 64.f)) + 1;
                    AUnit u{b * SEQ + 128 * qb, b * SEQ, 128 * qb, 128, 1 << 30, h, max(0, 2 * qb - win), 2 * qb + 1};
                    if (smax * LOG2E < 40.f) ATT2F(lds, QA, KA, VA, QA, u, nullptr, nullptr, nullptr, nullptr, win, slope * LOG2E, lam, subg, osc, tab, smax * LOG2E);
                    else ATT2(lds, QA, KA, VA, QA, u, nullptr, nullptr, nullptr, nullptr, win, slope * LOG2E, lam, subg, osc, tab, mref0);
                } else {
                    idx -= 32 + QND(x); const int id = x * 128 + idx, bh = id >> 6, qb = id & 63, b = bh >> 3, h = bh & 7;
                    if (tda < 257) tab[tda] = relb[h * 257 + tda] * LOG2E;
                    const int c0 = 4 * qb;
                    AUnit u{b * SEQ + 256 * qb, b * SEQ, 256 * qb, 256, 1 << 30, h, max(0, c0 - 8), c0 + 3};
                    ATT1(lds, QB, KB, VB, QB, u, nullptr, nullptr, nullptr, nullptr, 8, 0.f, 0.f, nullptr, 1.f, tab, mref0);
                }
            }
#undef QND
        }
        FSYNC();

        {
            pg8::Gemm g{QB, (const bf16_t*)(wl + WL_BRB), MT, 1024, 512}; pg8::StaticOrder S; S.init(MT, 1024, G, bx);
            EpiGate<false> E{XN, GATE + 1024};
            pg8::gemm_phase<EpiGate<false>, pg8::StaticOrder, true, true>(lds, g, S, E);
        }
        {
            pg8::Gemm g{QA, (const bf16_t*)(wl + WL_BRA), MT, 1024, 1024}; pg8::StaticOrder S; S.init(MT, 1024, G, bx);
            EpiGate<true> E{XN, GATE};
            pg8::gemm_phase<EpiGate<true>, pg8::StaticOrder, true, true>(lds, g, S, E);
        }
        FSYNC();
        {
            pg8::Gemm g{XN, (const bf16_t*)(wl + WL_OUT), MP, 1024, 1024}; pg8::StaticOrder S; S.init(MP, 1024, G, bx);
            EpiResid E{(l == 0) ? a.in[I_XP] : Y, (l == 0) ? a.in[I_XS] : Y + (size_t)MP * 1024, X1};
            pg8::gemm_phase<EpiResid, pg8::StaticOrder, true, true>(lds, g, S, E);
            int bxo = bx; asm volatile("" : "+s"(bxo));
            for (int it = bxo; it < 256; it += G) skinny_splitk(XN + (size_t)MP * 1024, (const bf16_t*)(wl + WL_OUT), 1024, X1 + (size_t)MP * 1024, it);
        }
        FSYNC();
        { int ln2 = LANEX; asm volatile("" : "+v"(ln2));
          int gwo2 = gw; asm volatile("" : "+s"(gwo2));
          for (int m = gwo2; m < MT; m += 2 * NGW) { const int m2 = (m + NGW < MT) ? m + NGW : m;
              rms_row2(X1 + (size_t)m * 1024, X1 + (size_t)m2 * 1024, a.in[I_N2G] + l * 1024, XN + (size_t)m * 1024, XN + (size_t)m2 * 1024, ln2); }
          for (int m = gwo2; m < MS; m += NGW) copy_row(X1 + (size_t)(MP + m) * 1024, Y + (size_t)(MP + m) * 1024, ln2); }
        FSYNC();
        {
            pg8::Gemm g{XN, (const bf16_t*)(wl + WL_FF1), MT, DFF, 1024}; pg8::StaticOrder S; S.init(MT, DFF, G, bx);
            EpiRelu2 E{UB};
            pg8::gemm_phase<EpiRelu2, pg8::StaticOrder, true, true>(lds, g, S, E);
        }
        FSYNC();
        {
            pg8::Gemm g{UB, (const bf16_t*)(wl + WL_FF2), MP, 1024, DFF}; pg8::StaticOrder S; S.init(MP, 1024, G, bx);
            EpiResid E{X1, X1 + (size_t)MP * 1024, Y};
            pg8::gemm_phase<EpiResid, pg8::StaticOrder, true, true>(lds, g, S, E);
            int bxo = bx; asm volatile("" : "+s"(bxo));
            for (int it = bxo; it < 256; it += G) skinny_splitk(UB + (size_t)MP * DFF, (const bf16_t*)(wl + WL_FF2), DFF, Y + (size_t)MP * 1024, it);
        }
        if (l == 0) FSYNC();
    }
}

extern "C" void kernel_launch(void* const* d_in, const int* in_sizes, int n_in, void* d_out, int out_size, void* d_ws, size_t ws_size, hipStream_t stream) {
    static int grid = 0;
    if (grid == 0) {
        if (n_in != 25 || ws_size < WS_END + 32768) { fprintf(stderr, "kernel_launch: unexpected n_in %d / ws %zu\n", n_in, ws_size); grid = -1; return; }
        int dev = 0, cus = 0, per_cu = 0;
        hipGetDevice(&dev); hipDeviceGetAttribute(&cus, hipDeviceAttributeMultiprocessorCount, dev);
        if (hipFuncSetAttribute((const void*)fwd_kernel, hipFuncAttributeMaxDynamicSharedMemorySize, LDS_BYTES) != hipSuccess) { fprintf(stderr, "kernel_launch: hipFuncSetAttribute failed\n"); }
        if (hipOccupancyMaxActiveBlocksPerMultiprocessor(&per_cu, (const void*)fwd_kernel, 512, LDS_BYTES) != hipSuccess || per_cu < 1) { fprintf(stderr, "kernel_launch: occupancy query says %d\n", per_cu); per_cu = 1; }
        (void)hipGetLastError();
        grid = cus * 1;
    }
    if (grid < 0) return;
    if (hipMemsetAsync((char*)d_ws + WS_CTR, 0, 32768, stream) != hipSuccess) { fprintf(stderr, "kernel_launch: memset of the control words failed\n"); return; }
    Args a{};
    for (int i = 0; i < 25; ++i) a.in[i] = (const float*)d_in[i];
    a.out = (float*)d_out; a.ws = (unsigned char*)d_ws;
    void* args[] = {&a};
    hipError_t e = hipLaunchCooperativeKernel((const void*)fwd_kernel, dim3(grid), dim3(512), args, LDS_BYTES, stream);
    if (e != hipSuccess) fprintf(stderr, "cooperative launch failed: %s (grid %d)\n", hipGetErrorString(e), grid);
}
```

```cpp
#include <hip/hip_runtime.h>
#include <hip/hip_cooperative_groups.h>
#include <cstdio>
#include <cstdint>
namespace cg = cooperative_groups;

#define LAS __attribute__((address_space(3)))
typedef unsigned short bf16_t;
typedef short bf16x8 __attribute__((ext_vector_type(8)));
typedef short s16x4 __attribute__((ext_vector_type(4)));
typedef float f32x4 __attribute__((ext_vector_type(4)));
typedef float f32x16 __attribute__((ext_vector_type(16)));
typedef unsigned u32x4 __attribute__((ext_vector_type(4)));
typedef unsigned u32x2 __attribute__((ext_vector_type(2)));

constexpr int DM = 1024, SEQ = 16384, MP = 2 * SEQ, MS = 256, MT = MP + MS;
constexpr int NIN = 4608, NG1 = 6656, DFF = 4096;
constexpr int SA_LEN = 2112, SB_LEN = 576;
constexpr int KA_ROWS = MP + 16 * SA_LEN, KB_ROWS = MP + 16 * SB_LEN;
constexpr float EPS = 1e-6f, LOG2E = 1.4426950408889634f, C2 = 0.125f * LOG2E;
constexpr size_t O_Y = 0, O_AK_P = 33816576, O_AV_P = 100925440, O_BK_P = 168034304, O_BV_P = 169082880,
                 O_AK_S = 170131456, O_AV_S = 170655744, O_BK_S = 171180032, O_BV_S = 171442176;
constexpr size_t MiB = 1u << 20;
constexpr size_t WL_W1 = 0, WL_BRA = 13631488, WL_BRB = WL_BRA + 2097152, WL_OUT = WL_BRB + 1048576, WL_FF1 = WL_OUT + 2097152, WL_FF2 = WL_FF1 + 8388608, WL_SIZE = 34 * MiB;
constexpr size_t WS_W = 0, WS_XN = 68 * MiB, WS_X1 = WS_XN + 65 * MiB, WS_QA = WS_X1 + 129 * MiB, WS_QB = WS_QA + 65 * MiB, WS_KA = WS_QB + 33 * MiB,
                 WS_VA = WS_KA + 130 * MiB, WS_KB = WS_VA + 130 * MiB, WS_VB = WS_KB + 41 * MiB, WS_GATE = WS_VB + 41 * MiB, WS_END = WS_GATE + 129 * MiB;
constexpr size_t WS_CTR = WS_END;
constexpr size_t WS_U = WS_KA;
static_assert((size_t)KA_ROWS * 1024 * 2 <= 130 * MiB && (size_t)MT * 4096 * 2 <= 260 * MiB && (size_t)KB_ROWS * 512 * 2 <= 41 * MiB && WS_END <= 1024 * MiB, "ws map");

constexpr int GEMM_LDS = 131072, LDS_BYTES = 147456;

__device__ __forceinline__ unsigned cvt_pk_bf16(float lo, float hi) { unsigned r; asm volatile("v_cvt_pk_bf16_f32 %0, %1, %2" : "=v"(r) : "v"(lo), "v"(hi)); return r; }
__device__ __forceinline__ unsigned f2bf(float f) { unsigned u = __builtin_bit_cast(unsigned, f); return (u + 0x7fffu + ((u >> 16) & 1u)) >> 16; }
__device__ __forceinline__ unsigned pk2(float lo, float hi) { return f2bf(lo) | (f2bf(hi) << 16); }
__device__ __forceinline__ float bf2f(unsigned short b) { return __builtin_bit_cast(float, (unsigned)b << 16); }


__device__ __forceinline__ void swap32(float& a, float& b) { asm volatile("s_nop 1\n\tv_permlane32_swap_b32 %0, %1\n\ts_nop 1" : "+v"(a), "+v"(b)); }
__device__ __forceinline__ void swap16(float& a, float& b) { asm volatile("s_nop 1\n\tv_permlane16_swap_b32 %0, %1\n\ts_nop 1" : "+v"(a), "+v"(b)); }
__device__ __forceinline__ float x32_sum(float v) { float a = v, b = v; swap32(a, b); return a + b; }
__device__ __forceinline__ float x32_max(float v) { float a = v, b = v; swap32(a, b); return fmaxf(a, b); }
__device__ __forceinline__ float x16_sum(float v) { float a = v, b = v; swap16(a, b); return a + b; }
__device__ __forceinline__ float dpp_add(float v, const int ctrl_sel) {
    int t;
    if (ctrl_sel == 0) t = __builtin_amdgcn_mov_dpp(__builtin_bit_cast(int, v), 0xB1, 0xf, 0xf, true);
    else if (ctrl_sel == 1) t = __builtin_amdgcn_mov_dpp(__builtin_bit_cast(int, v), 0x4E, 0xf, 0xf, true);
    else if (ctrl_sel == 2) t = __builtin_amdgcn_mov_dpp(__builtin_bit_cast(int, v), 0x141, 0xf, 0xf, true);
    else t = __builtin_amdgcn_mov_dpp(__builtin_bit_cast(int, v), 0x140, 0xf, 0xf, true);
    return v + __builtin_bit_cast(float, t);
}
__device__ __forceinline__ float dpp_max(float v, const int ctrl_sel) {
    int t;
    if (ctrl_sel == 0) t = __builtin_amdgcn_mov_dpp(__builtin_bit_cast(int, v), 0xB1, 0xf, 0xf, true);
    else if (ctrl_sel == 1) t = __builtin_amdgcn_mov_dpp(__builtin_bit_cast(int, v), 0x4E, 0xf, 0xf, true);
    else if (ctrl_sel == 2) t = __builtin_amdgcn_mov_dpp(__builtin_bit_cast(int, v), 0x141, 0xf, 0xf, true);
    else t = __builtin_amdgcn_mov_dpp(__builtin_bit_cast(int, v), 0x140, 0xf, 0xf, true);
    return fmaxf(v, __builtin_bit_cast(float, t));
}
__device__ __forceinline__ float wave_max(float v) { v = dpp_max(v, 0); v = dpp_max(v, 1); v = dpp_max(v, 2); v = dpp_max(v, 3); { float a = v, b = v; swap16(a, b); v = fmaxf(a, b); } return x32_max(v); }
__device__ __forceinline__ float wave_sum(float v) { v = dpp_add(v, 0); v = dpp_add(v, 1); v = dpp_add(v, 2); v = dpp_add(v, 3); v = x16_sum(v); return x32_sum(v); }

namespace pg8 {
#define PG8_LAS __attribute__((address_space(3)))
constexpr int BM = 256, BK = 64, HALF = 128, HTB = HALF * BK * 2, STAGE_BYTES = 8 * HTB, NXCD = 8, WGM = 8;
__host__ __device__ __forceinline__ int lds_byte(int r, int c) { const int st = (r >> 4) * 2 + (c >> 5), rr = r & 15, cc = c & 31, ob = rr * 64 + cc * 2; return st * 1024 + (ob ^ (((ob >> 9) & 1) << 5)); }
__host__ __device__ __forceinline__ void stage_rc(int b, int& R, int& C) { const int st = b / 1024, sb = b % 1024, swz = sb ^ (((sb >> 9) & 1) << 5); R = (st >> 1) * 16 + swz / 64; C = (st & 1) * 32 + (swz % 64) / 2; }
__host__ __device__ __forceinline__ int perm32(int rho) { const int n = rho >> 4, i = rho & 15; return 8 * (i >> 2) + 4 * n + (i & 3); }
struct Unit { int pm, pn; };
struct Gemm { const bf16_t* A; const bf16_t* Bt; int M, N, K; };
struct StaticOrder {
    int nM, nN, nwg, G, c;
    __host__ __device__ void init(int M, int N, int G_, int c_) { nM = M / BM; nN = N / BM; nwg = nM * nN; G = G_; c = c_; }
    __host__ __device__ bool next(int i, Unit& u) const {
        const long L = (long)i * G + c; if (L >= nwg) return false;
        int wgid = (int)L; { const int q = nwg / NXCD, r = nwg % NXCD, xcd = wgid % NXCD, off = wgid / NXCD; wgid = (xcd < r ? xcd * (q + 1) : r * (q + 1) + (xcd - r) * q) + off; }
        const int nig = WGM * nN, gid = wgid / nig, fm = gid * WGM, gsz = (nM - fm) < WGM ? (nM - fm) : WGM;
        u.pm = fm + ((wgid % nig) % gsz); u.pn = (wgid % nig) / gsz; return true;
    }
    __device__ __forceinline__ void a_ready(const Unit&) const {}
    __device__ __forceinline__ void done(const Unit&) const {}
};
template <class Epi, class Sched, bool ALIGN_EPI = false, bool SP2 = false>
__device__ __forceinline__ void gemm_phase(PG8_LAS unsigned char* lds, const Gemm g, const Sched& S, const Epi& E) {
    int tid = threadIdx.x; asm volatile("" : "+v"(tid));
    const int wid = __builtin_amdgcn_readfirstlane(tid >> 6), lane = tid & 63, wr = wid >> 2, wc = wid & 3, fr = lane & 15, fq = lane >> 4;
    const int K = g.K, nt = K / BK;
    unsigned voffA[2], voffB[2];
#pragma unroll
    for (int i = 0; i < 2; ++i) { int R, C; stage_rc(tid * 16 + i * 8192, R, C); const int Rb = Epi::PERM ? ((R & ~31) + perm32(R & 31)) : R;
        voffA[i] = (unsigned)(R * K + C) * 2u; voffB[i] = (unsigned)(Rb * K + C) * 2u; }
    const size_t kstep = (size_t)(BK * 2);
    const size_t hstep = (size_t)HALF * K * 2;
    const size_t tstep = 2 * hstep;
    const unsigned ldsw = (unsigned)wid * 1024u;
    const int aoff = lds_byte(wr * 64 + fr, fq * 8), boff = lds_byte(wc * 32 + fr, fq * 8);
#define PG8_SA(b, h) (((b) * 2 + (h)) * HTB)
#define PG8_SB(b, h) ((4 + (b) * 2 + (h)) * HTB)
#define PG8_STAGE(bufoff, gbase, voff) do { _Pragma("unroll") for (int _i = 0; _i < 2; ++_i) \
        __builtin_amdgcn_global_load_lds((const unsigned*)((const char*)(gbase) + (voff)[_i]), (PG8_LAS unsigned*)(lds + (bufoff) + ldsw + _i * 8192), 16, 0, 0); } while (0)
#define PG8_LDA(dst, b, h) do { _Pragma("unroll") for (int m = 0; m < 4; ++m) _Pragma("unroll") for (int k = 0; k < 2; ++k) dst[m][k] = *(const PG8_LAS bf16x8*)(lds + PG8_SA(b, h) + aoff + m * 2048 + k * 1024); } while (0)
#define PG8_LDB(dst, b, h) do { _Pragma("unroll") for (int n = 0; n < 2; ++n) _Pragma("unroll") for (int k = 0; k < 2; ++k) dst[n][k] = *(const PG8_LAS bf16x8*)(lds + PG8_SB(b, h) + boff + n * 2048 + k * 1024); } while (0)
#define PG8_MMA(ai, bj, At, Bt) do { __builtin_amdgcn_s_setprio(1); _Pragma("unroll") for (int m = 0; m < 4; ++m) _Pragma("unroll") for (int n = 0; n < 2; ++n) _Pragma("unroll") for (int k = 0; k < 2; ++k) \
        acc[ai][bj][m][n] = __builtin_amdgcn_mfma_f32_16x16x32_bf16(Bt[n][k], At[m][k], acc[ai][bj][m][n], 0, 0, 0); __builtin_amdgcn_s_setprio(0); } while (0)
#define PG8_WAIT_V(n) asm volatile("s_waitcnt vmcnt(" #n ")" ::: "memory")
#define PG8_WAIT_L(n) asm volatile("s_waitcnt lgkmcnt(" #n ")" ::: "memory")
#define PG8_BAR __builtin_amdgcn_s_barrier()
#define PG8_SCHED __builtin_amdgcn_sched_barrier(0)
    Unit cur, nxt; int ui = 0;
    if (!S.next(0, cur)) return;
    f32x4 acc[2][2][4][2];
#pragma unroll
    for (int a = 0; a < 2; ++a)
#pragma unroll
        for (int b = 0; b < 2; ++b)
#pragma unroll
            for (int m = 0; m < 4; ++m)
#pragma unroll
                for (int n = 0; n < 2; ++n) acc[a][b][m][n] = (f32x4){0.f, 0.f, 0.f, 0.f};
    bf16x8 At[4][2], B0[2][2], B1[2][2];
    const char* cA = (const char*)g.A + (size_t)cur.pm * tstep; const char* cB = (const char*)g.Bt + (size_t)cur.pn * tstep;
    S.a_ready(cur);
    if constexpr (SP2) {
        PG8_STAGE(PG8_SB(0, 0), cB, voffB); PG8_STAGE(PG8_SB(0, 1), cB + hstep, voffB); PG8_STAGE(PG8_SA(0, 0), cA, voffA); PG8_STAGE(PG8_SA(0, 1), cA + hstep, voffA);
        if (wr == 1) PG8_BAR;
        PG8_WAIT_V(2); PG8_BAR;
        PG8_STAGE(PG8_SB(1, 0), cB + kstep, voffB); PG8_STAGE(PG8_SA(1, 0), cA + kstep, voffA); PG8_STAGE(PG8_SB(1, 1), cB + hstep + kstep, voffB);
        PG8_WAIT_V(6); PG8_BAR;
    } else {
        PG8_STAGE(PG8_SB(0, 0), cB, voffB); PG8_STAGE(PG8_SA(0, 0), cA, voffA); PG8_STAGE(PG8_SB(0, 1), cB + hstep, voffB); PG8_STAGE(PG8_SA(0, 1), cA + hstep, voffA);
        if (wr == 1) PG8_BAR;
        PG8_WAIT_V(4); PG8_BAR;
        PG8_STAGE(PG8_SB(1, 0), cB + kstep, voffB); PG8_STAGE(PG8_SA(1, 0), cA + kstep, voffA); PG8_STAGE(PG8_SB(1, 1), cB + hstep + kstep, voffB);
        PG8_WAIT_V(6); PG8_BAR;
    }
    for (;;) {
        const bool has_next = S.next(ui + 1, nxt);
        const char* nA = has_next ? (const char*)g.A + (size_t)nxt.pm * tstep : cA; const char* nB = has_next ? (const char*)g.Bt + (size_t)nxt.pn * tstep : cB;
        for (int t = 0; t < nt; t += 2) {
            const bool last = (t == nt - 2);
            const char* a1 = cA + (size_t)(t + 1) * kstep;
            const char* a2 = last ? nA : cA + (size_t)(t + 2) * kstep; const char* b2 = last ? nB : cB + (size_t)(t + 2) * kstep;
            const char* a3 = a2 + kstep; const char* b3 = b2 + kstep;
            if (last && has_next) S.a_ready(nxt);
            if constexpr (SP2) {
            PG8_LDB(B0, 0, 0); PG8_LDB(B1, 0, 1); PG8_SCHED; PG8_LDA(At, 0, 0); PG8_STAGE(PG8_SA(1, 1), a1 + hstep, voffA);
            PG8_WAIT_V(8); PG8_WAIT_L(0); PG8_BAR; PG8_MMA(0, 0, At, B0); PG8_MMA(0, 1, At, B1); PG8_BAR; PG8_SCHED;
            PG8_LDA(At, 0, 1); PG8_STAGE(PG8_SB(0, 0), b2, voffB); PG8_STAGE(PG8_SB(0, 1), b2 + hstep, voffB); PG8_STAGE(PG8_SA(0, 0), a2, voffA);
            PG8_WAIT_V(8); PG8_WAIT_L(0); PG8_BAR; PG8_MMA(1, 0, At, B0); PG8_MMA(1, 1, At, B1); PG8_BAR; PG8_SCHED;
            PG8_LDB(B0, 1, 0); PG8_LDB(B1, 1, 1); PG8_SCHED; PG8_LDA(At, 1, 0); PG8_STAGE(PG8_SA(0, 1), a2 + hstep, voffA);
            PG8_WAIT_V(8); PG8_WAIT_L(0); PG8_BAR; PG8_MMA(0, 0, At, B0); PG8_MMA(0, 1, At, B1); PG8_BAR; PG8_SCHED;
            PG8_LDA(At, 1, 1); PG8_STAGE(PG8_SB(1, 0), b3, voffB); PG8_STAGE(PG8_SB(1, 1), b3 + hstep, voffB); PG8_STAGE(PG8_SA(1, 0), a3, voffA);
            PG8_WAIT_V(8); PG8_WAIT_L(0); PG8_BAR; PG8_MMA(1, 0, At, B0); PG8_MMA(1, 1, At, B1); PG8_BAR; PG8_SCHED;
            } else {
            PG8_LDB(B0, 0, 0); PG8_SCHED; PG8_LDA(At, 0, 0); PG8_STAGE(PG8_SA(1, 1), a1 + hstep, voffA);
            PG8_WAIT_L(8); PG8_BAR; PG8_WAIT_L(0); PG8_MMA(0, 0, At, B0); PG8_BAR; PG8_SCHED;
            PG8_LDB(B1, 0, 1); PG8_STAGE(PG8_SB(0, 0), b2, voffB);
            PG8_BAR; PG8_WAIT_L(0); PG8_MMA(0, 1, At, B1); PG8_BAR;
            PG8_LDA(At, 0, 1); PG8_STAGE(PG8_SA(0, 0), a2, voffA);
            PG8_BAR; PG8_WAIT_L(0); PG8_MMA(1, 0, At, B0); PG8_BAR; PG8_SCHED;
            PG8_STAGE(PG8_SB(0, 1), b2 + hstep, voffB);
            PG8_WAIT_V(6); PG8_BAR; PG8_MMA(1, 1, At, B1); PG8_BAR;
            PG8_LDB(B0, 1, 0); PG8_SCHED; PG8_LDA(At, 1, 0); PG8_STAGE(PG8_SA(0, 1), a2 + hstep, voffA);
            PG8_WAIT_L(8); PG8_BAR; PG8_WAIT_L(0); PG8_MMA(0, 0, At, B0); PG8_BAR; PG8_SCHED;
            PG8_LDB(B1, 1, 1); PG8_STAGE(PG8_SB(1, 0), b3, voffB);
            PG8_BAR; PG8_WAIT_L(0); PG8_MMA(0, 1, At, B1); PG8_BAR;
            PG8_LDA(At, 1, 1); PG8_STAGE(PG8_SA(1, 0), a3, voffA);
            PG8_BAR; PG8_WAIT_L(0); PG8_MMA(1, 0, At, B0); PG8_BAR; PG8_SCHED;
            PG8_STAGE(PG8_SB(1, 1), b3 + hstep, voffB);
            PG8_WAIT_V(6); PG8_BAR; PG8_MMA(1, 1, At, B1); PG8_BAR;
            }
        }
        if constexpr (ALIGN_EPI) { if (wr == 0) PG8_BAR; }
        E(acc, cur, wr, wc, fr, fq); S.done(cur);
        if (!has_next) break;
#pragma unroll
        for (int a = 0; a < 2; ++a)
#pragma unroll
            for (int b = 0; b < 2; ++b)
#pragma unroll
                for (int m = 0; m < 4; ++m)
#pragma unroll
                    for (int n = 0; n < 2; ++n) acc[a][b][m][n] = (f32x4){0.f, 0.f, 0.f, 0.f};
        cur = nxt; cA = nA; cB = nB; ++ui;
        if constexpr (ALIGN_EPI) { if (wr == 1) PG8_BAR; }
    }
    PG8_WAIT_V(0);
    if constexpr (!ALIGN_EPI) { if (wr == 0) PG8_BAR; }
    PG8_BAR;
#undef PG8_SA
#undef PG8_SB
#undef PG8_STAGE
#undef PG8_LDA
#undef PG8_LDB
#undef PG8_MMA
#undef PG8_WAIT_V
#undef PG8_WAIT_L
#undef PG8_BAR
#undef PG8_SCHED
}
}

typedef const f32x4 (&AccRef)[2][2][4][2];
__device__ __forceinline__ void st8_bf16(bf16_t* p, f32x4 a, f32x4 b) { u32x4 w; w.x = cvt_pk_bf16(a[0], a[1]); w.y = cvt_pk_bf16(a[2], a[3]); w.z = cvt_pk_bf16(b[0], b[1]); w.w = cvt_pk_bf16(b[2], b[3]); *(u32x4*)p = w; }
__device__ __forceinline__ void ld8_bf16(const bf16_t* p, f32x4& a, f32x4& b) { const u32x4 w = *(const u32x4*)p;
    a = (f32x4){__builtin_bit_cast(float, w.x << 16), __builtin_bit_cast(float, w.x & 0xffff0000u), __builtin_bit_cast(float, w.y << 16), __builtin_bit_cast(float, w.y & 0xffff0000u)};
    b = (f32x4){__builtin_bit_cast(float, w.z << 16), __builtin_bit_cast(float, w.z & 0xffff0000u), __builtin_bit_cast(float, w.w << 16), __builtin_bit_cast(float, w.w & 0xffff0000u)}; }

struct EpiG1 {
    static constexpr bool PERM = true;
    bf16_t *QA, *KA, *VA, *QB, *KB, *VB, *GATE; float* out; int layer;
    const float *qn_a, *kn_a, *qn_b, *kn_b;
    __device__ __forceinline__ void operator()(AccRef acc, const pg8::Unit& u, int wr, int wc, int fr, int fq) const {
        const int pn = u.pn, lc = pn * 256 + wc * 64 + fq * 8;
        const bool samp = (u.pm >= 128);
        int mode; const float* g = nullptr; float scale = 1.f; bf16_t* dst; int pitch, cb, rowmap; float* fo = nullptr; int fpitch = 0;
        if (pn < 4)       { mode = 0; g = qn_a; scale = C2; dst = QA; pitch = 1024; cb = lc; rowmap = 0; }
        else if (pn < 8)  { mode = 0; g = kn_a; dst = KA; pitch = 1024; cb = lc - 1024; rowmap = 1; fpitch = 1024; fo = out + (samp ? O_AK_S + (size_t)layer * 262144 : O_AK_P + (size_t)layer * 33554432); }
        else if (pn < 12) { mode = 1; dst = VA; pitch = 1024; cb = lc - 2048; rowmap = 1; fpitch = 1024; fo = out + (samp ? O_AV_S + (size_t)layer * 262144 : O_AV_P + (size_t)layer * 33554432); }
        else if (pn < 14) { mode = 0; g = qn_b; scale = C2; dst = QB; pitch = 512; cb = lc - 3072; rowmap = 0; }
        else if (pn < 16) { mode = 0; g = kn_b; dst = KB; pitch = 512; cb = lc - 3584; rowmap = 2; fpitch = 512;
                            if (samp) fo = out + O_BK_S + (size_t)layer * 131072; else if ((u.pm & 63) >= 62) fo = out + O_BK_P + (size_t)layer * 524288; }
        else if (pn < 18) { mode = 1; dst = VB; pitch = 512; cb = lc - 4096; rowmap = 2; fpitch = 512;
                            if (samp) fo = out + O_BV_S + (size_t)layer * 131072; else if ((u.pm & 63) >= 62) fo = out + O_BV_P + (size_t)layer * 524288; }
        else              { mode = 2; dst = GATE; pitch = 2048; cb = lc - 4608; rowmap = 0; }
        float one = 1.f; asm volatile("" : "+v"(one));
        f32x4 gv[2][2];
        if (mode == 0) {
#pragma unroll
            for (int bj = 0; bj < 2; ++bj)
#pragma unroll
                for (int n = 0; n < 2; ++n) gv[bj][n] = *(const f32x4*)(g + bj * 32 + fq * 8 + n * 4) * scale;
        }
#pragma unroll
        for (int ai = 0; ai < 2; ++ai)
#pragma unroll
            for (int m = 0; m < 4; ++m) {
                const int row = u.pm * 256 + ai * 128 + wr * 64 + m * 16 + fr;
                f32x4 v[2][2];
#pragma unroll
                for (int bj = 0; bj < 2; ++bj)
#pragma unroll
                    for (int n = 0; n < 2; ++n) v[bj][n] = acc[ai][bj][m][n];
                if (mode == 0) {
                    float ss = 0.f;
#pragma unroll
                    for (int bj = 0; bj < 2; ++bj)
#pragma unroll
                        for (int n = 0; n < 2; ++n) { const f32x4 x = v[bj][n]; ss += (x[0] * x[0] + x[1] * x[1]) + (x[2] * x[2] + x[3] * x[3]); }
                    ss = x16_sum(ss); ss = x32_sum(ss);
                    const float rs = __builtin_amdgcn_rsqf(ss * (1.f / 64.f) + EPS);
#pragma unroll
                    for (int bj = 0; bj < 2; ++bj)
#pragma unroll
                        for (int n = 0; n < 2; ++n) v[bj][n] = v[bj][n] * rs * gv[bj][n];
                } else if (mode == 1) {
#pragma unroll
                    for (int bj = 0; bj < 2; ++bj)
#pragma unroll
                        for (int n = 0; n < 2; ++n) v[bj][n] = v[bj][n] * one;
                } else {
#pragma unroll
                    for (int bj = 0; bj < 2; ++bj)
#pragma unroll
                        for (int n = 0; n < 2; ++n)
#pragma unroll
                            for (int i = 0; i < 4; ++i) v[bj][n][i] = __builtin_amdgcn_rcpf(1.f + __builtin_amdgcn_exp2f(-LOG2E * v[bj][n][i]));
                }
                size_t drow;
                if (rowmap == 0 || !samp) drow = (size_t)row;
                else { const int r = row - MP, s = r >> 4, t = r & 15; drow = (rowmap == 1) ? (size_t)(MP + s * SA_LEN + 2048 + t) : (size_t)(MP + s * SB_LEN + 512 + t); }
                bf16_t* dp = dst + drow * pitch + cb;
#pragma unroll
                for (int bj = 0; bj < 2; ++bj) st8_bf16(dp + bj * 32, v[bj][0], v[bj][1]);
                if (fo) {
                    size_t frow;
                    if (samp) frow = (size_t)(row - MP);
                    else if (fpitch == 1024) frow = (size_t)row;
                    else frow = (size_t)((row >> 14) * 512 + (row & 16383) - 15872);
                    float* fp = fo + frow * fpitch + cb;
#pragma unroll
                    for (int bj = 0; bj < 2; ++bj) { *(f32x4*)(fp + bj * 32) = v[bj][0]; *(f32x4*)(fp + bj * 32 + 4) = v[bj][1]; }
                }
            }
    }
};
template <bool ADD> struct EpiGate {
    static constexpr bool PERM = true;
    bf16_t* Mb; const bf16_t* gate;
    __device__ __forceinline__ void operator()(AccRef acc, const pg8::Unit& u, int wr, int wc, int fr, int fq) const {
        const int lc = u.pn * 256 + wc * 64 + fq * 8;
#pragma unroll
        for (int ai = 0; ai < 2; ++ai)
#pragma unroll
            for (int m = 0; m < 4; ++m) {
                const size_t row = (size_t)(u.pm * 256 + ai * 128 + wr * 64 + m * 16 + fr);
#pragma unroll
                for (int bj = 0; bj < 2; ++bj) {
                    f32x4 g0, g1; ld8_bf16(gate + row * 2048 + lc + bj * 32, g0, g1);
                    f32x4 v0 = acc[ai][bj][m][0] * g0, v1 = acc[ai][bj][m][1] * g1;
                    bf16_t* mp = Mb + row * 1024 + lc + bj * 32;
                    if (ADD) { f32x4 p0, p1; ld8_bf16(mp, p0, p1); v0 += p0; v1 += p1; }
                    st8_bf16(mp, v0, v1);
                }
            }
    }
};
struct EpiResid {
    static constexpr bool PERM = true;
    const float* srcP; const float* srcS; float* dst;
    __device__ __forceinline__ void operator()(AccRef acc, const pg8::Unit& u, int wr, int wc, int fr, int fq) const {
        const int lc = u.pn * 256 + wc * 64 + fq * 8;
        const float* sb = (u.pm >= 128) ? srcS - (size_t)MP * 1024 : srcP;
#pragma unroll
        for (int ai = 0; ai < 2; ++ai)
#pragma unroll
            for (int m = 0; m < 4; ++m) {
                const size_t off = (size_t)(u.pm * 256 + ai * 128 + wr * 64 + m * 16 + fr) * 1024 + lc;
#pragma unroll
                for (int bj = 0; bj < 2; ++bj)
#pragma unroll
                    for (int n = 0; n < 2; ++n) { const f32x4 s = *(const f32x4*)(sb + off + bj * 32 + n * 4); *(f32x4*)(dst + off + bj * 32 + n * 4) = s + acc[ai][bj][m][n]; }
            }
    }
};
struct EpiRelu2 {
    static constexpr bool PERM = true;
    bf16_t* U;
    __device__ __forceinline__ void operator()(AccRef acc, const pg8::Unit& u, int wr, int wc, int fr, int fq) const {
        const int lc = u.pn * 256 + wc * 64 + fq * 8;
#pragma unroll
        for (int ai = 0; ai < 2; ++ai)
#pragma unroll
            for (int m = 0; m < 4; ++m) {
                bf16_t* up = U + (size_t)(u.pm * 256 + ai * 128 + wr * 64 + m * 16 + fr) * DFF + lc;
#pragma unroll
                for (int bj = 0; bj < 2; ++bj) { f32x4 a = acc[ai][bj][m][0], b = acc[ai][bj][m][1];
#pragma unroll
                    for (int i = 0; i < 4; ++i) { const float x = fmaxf(a[i], 0.f), y = fmaxf(b[i], 0.f); a[i] = x * x; b[i] = y * y; }
                    st8_bf16(up + bj * 32, a, b); }
            }
    }
};

struct AUnit { int qrow0, kvrow0, qloc0, nq, nk, h, jlo, jhi; };
#define MFMA32(a, b, c) __builtin_amdgcn_mfma_f32_32x32x16_bf16((a), (b), (c), 0, 0, 0)
__device__ __forceinline__ s16x4 vtr(const LAS unsigned char* p) { return __builtin_bit_cast(s16x4, __builtin_amdgcn_ds_read_tr16_b64_v4i16((LAS s16x4*)p)); }

template <bool DIFF, bool FIXED, bool F32SRC>
__device__ __forceinline__ void attn_unit(LAS unsigned char* lds, const bf16_t* Q, const bf16_t* __restrict__ K, const bf16_t* __restrict__ V, bf16_t* O, const AUnit u,
                                          const float* __restrict__ kc, const float* __restrict__ vc, const float* __restrict__ kn, const float* __restrict__ vn,
                                          const int win, const float slopeL2, const float lam, const float* subln_g, const float osc, const LAS float* tab, const float mref0) {
    constexpr int HW = DIFF ? 128 : 64, PITCH = DIFF ? 1024 : 512, NDB = HW / 32, NCH = HW / 64, RB = HW * 2;
    constexpr int KBUF = 64 * RB, VBUF = 64 * RB, BUF = KBUF + VBUF;
    int tid = threadIdx.x; asm volatile("" : "+v"(tid));
    const int lane = tid & 63, w = __builtin_amdgcn_readfirstlane(tid >> 6), q32 = lane & 31, hi = lane >> 5;
    const int sub = DIFF ? (w & 1) : 0, qg = DIFF ? (w >> 1) : w;
    const bool wact = (32 * qg < u.nq);
    const int qloc = u.qloc0 + 32 * qg + q32, cq = (u.qloc0 + 32 * qg) >> 6;
    const bool qvalid = (32 * qg + q32) < u.nq;
    const int qrow = qvalid ? (u.qrow0 + 32 * qg + q32) : u.qrow0;
    bf16x8 qf[4];
#pragma unroll
    for (int ks = 0; ks < 4; ++ks) qf[ks] = *(const bf16x8*)(Q + (size_t)qrow * PITCH + u.h * HW + sub * 64 + ks * 16 + hi * 8);
    float mrun = mref0, lrun = 0.f; f32x16 o[NDB];
#pragma unroll
    for (int db = 0; db < NDB; ++db) o[db] = f32x16{};
    unsigned kgo[NCH], vgo[NCH];
#pragma unroll
    for (int i = 0; i < NCH; ++i) {
        const int piece = w * NCH + i;
        const int krow = DIFF ? (piece * 4 + (lane >> 4)) : (piece * 8 + (lane >> 3));
        const int kcp = DIFF ? (lane & 15) : (lane & 7);
        const int kch = kcp ^ (DIFF ? (krow & 15) : ((krow >> 1) & 7));
        kgo[i] = (unsigned)(krow * PITCH + kch * 8);
        const int p = piece * 64 + lane, st = p >> 5, key = 8 * (st / NDB) + ((p & 31) >> 2), dch = (st % NDB) * 4 + (p & 3);
        vgo[i] = (unsigned)(key * PITCH + dch * 8);
    }
#define ATT_DMA(j, b) do { const bf16_t* kt_ = K + (size_t)(u.kvrow0 + 64 * (j)) * PITCH + u.h * HW; const bf16_t* vt_ = V + (size_t)(u.kvrow0 + 64 * (j)) * PITCH + u.h * HW; \
        _Pragma("unroll") for (int i = 0; i < NCH; ++i) { \
            __builtin_amdgcn_global_load_lds((const unsigned*)(kt_ + kgo[i]), (LAS unsigned*)(lds + (b) * BUF + (w * NCH + i) * 1024), 16, 0, 0); \
            __builtin_amdgcn_global_load_lds((const unsigned*)(vt_ + vgo[i]), (LAS unsigned*)(lds + (b) * BUF + KBUF + (w * NCH + i) * 1024), 16, 0, 0); } } while (0)
#define ATT_WAIT_BAR(n) asm volatile("s_waitcnt vmcnt(" #n ")\n\ts_barrier" ::: "memory")
    const int vlane = (4 * hi + ((lane & 15) >> 2)) * 64 + ((lane >> 4) & 1) * 32 + (lane & 3) * 8;
    const int kswz = DIFF ? (q32 & 15) : ((q32 >> 1) & 7);
    int koff[4];
#pragma unroll
    for (int ks = 0; ks < 4; ++ks) koff[ks] = q32 * RB + (((sub * 8 + 2 * ks + hi) ^ kswz) << 4);
    int j = u.jhi, buf = 0;
    if (!F32SRC) {
    asm volatile("s_waitcnt vmcnt(0)" ::: "memory");
    ATT_DMA(j, 0);
    if (j - 1 >= u.jlo) { ATT_DMA(j - 1, 1); if (NCH == 2) ATT_WAIT_BAR(4); else ATT_WAIT_BAR(2); }
    else ATT_WAIT_BAR(0);
    }
    for (; j >= u.jlo; --j) {
        if (F32SRC) {
#pragma unroll
            for (int i = 0; i < NCH; ++i) {
                const int c = tid + 512 * i, row = c / (HW / 8), ch = c % (HW / 8);
                const size_t so = (j == u.jhi) ? (size_t)min(row, 15) * PITCH + u.h * HW + ch * 8 : (size_t)(64 * j + row) * PITCH + u.h * HW + ch * 8;
                const float* ks_ = ((j == u.jhi) ? kn : kc) + so; const float* vs_ = ((j == u.jhi) ? vn : vc) + so;
                const f32x4 k0 = ((const f32x4*)ks_)[0], k1 = ((const f32x4*)ks_)[1], v0 = ((const f32x4*)vs_)[0], v1 = ((const f32x4*)vs_)[1];
                u32x4 kw, vw; kw.x = pk2(k0.x, k0.y); kw.y = pk2(k0.z, k0.w); kw.z = pk2(k1.x, k1.y); kw.w = pk2(k1.z, k1.w); vw.x = pk2(v0.x, v0.y); vw.y = pk2(v0.z, v0.w); vw.z = pk2(v1.x, v1.y); vw.w = pk2(v1.z, v1.w);
                *(LAS u32x4*)(lds + buf * BUF + row * RB + ((ch ^ (DIFF ? (row & 15) : ((row >> 1) & 7))) << 4)) = kw;
                *(LAS u32x4*)(lds + buf * BUF + KBUF + (row >> 3) * (NDB * 512) + (ch >> 2) * 512 + (row & 7) * 64 + (ch & 3) * 16) = vw;
            }
            __syncthreads();
        } else {
        const int b2 = (buf >= 1) ? buf - 1 : 2;
        if (j - 2 >= u.jlo) ATT_DMA(j - 2, b2);
        }
        const bool comp = (wact && j <= cq && j >= cq - win);
        if (comp) {
            const LAS unsigned char* kb = lds + buf * BUF; const LAS unsigned char* vb = kb + KBUF;
            const int dqi = qloc - 64 * j - 4 * hi; const float dq = (float)dqi;
            bf16x8 kf0[2], kf1[2];
#pragma unroll
            for (int ks = 0; ks < 2; ++ks) { kf0[ks] = *(const LAS bf16x8*)(kb + koff[ks]); kf1[ks] = *(const LAS bf16x8*)(kb + koff[ks] + 32 * RB); }
            f32x16 a0, a1;
            if (DIFF) {
                if (j < cq) {
                    const float base = -slopeL2 * dq - mrun;
#pragma unroll
                    for (int r = 0; r < 16; ++r) { const float c = (float)((r & 3) + 8 * (r >> 2)); a0[r] = slopeL2 * c + base; a1[r] = slopeL2 * (c + 32.f) + base; }
                } else {
#pragma unroll
                    for (int r = 0; r < 16; ++r) { const float c = (float)((r & 3) + 8 * (r >> 2)); a0[r] = -slopeL2 * __builtin_fabsf(dq - c) - mrun; a1[r] = -slopeL2 * __builtin_fabsf(dq - (c + 32.f)) - mrun; }
                }
            } else {
                if (j <= cq - 3) {
                    const float t = tab[256] - mrun;
#pragma unroll
                    for (int r = 0; r < 16; ++r) { a0[r] = t; a1[r] = t; }
                } else {
#pragma unroll
                    for (int r = 0; r < 16; ++r) { const int c = (r & 3) + 8 * (r >> 2); int i0 = dqi - c, i1 = dqi - c - 32;
                        i0 = min(max(i0, -128), 128) + 128; i1 = min(max(i1, -128), 128) + 128; a0[r] = tab[i0] - mrun; a1[r] = tab[i1] - mrun; }
                }
            }
            if (64 * j + 64 > u.nk) {
#pragma unroll
                for (int r = 0; r < 16; ++r) { const int key = 64 * j + (r & 3) + 8 * (r >> 2) + 4 * hi; if (key >= u.nk) a0[r] = -1e30f; if (key + 32 >= u.nk) a1[r] = -1e30f; }
            }
            __builtin_amdgcn_sched_barrier(0);
#pragma unroll
            for (int ks = 0; ks < 2; ++ks) { a0 = MFMA32(kf0[ks], qf[ks], a0); a1 = MFMA32(kf1[ks], qf[ks], a1); }
            __builtin_amdgcn_sched_barrier(0);
#pragma unroll
            for (int ks = 0; ks < 2; ++ks) { kf0[ks] = *(const LAS bf16x8*)(kb + koff[ks + 2]); kf1[ks] = *(const LAS bf16x8*)(kb + koff[ks + 2] + 32 * RB); }
            __builtin_amdgcn_sched_barrier(0);
#pragma unroll
            for (int ks = 0; ks < 2; ++ks) { a0 = MFMA32(kf0[ks], qf[ks + 2], a0); a1 = MFMA32(kf1[ks], qf[ks + 2], a1); }
            __builtin_amdgcn_sched_barrier(0);
            bf16x8 vf[4];
#define ATT_VLOAD(dst, db) do { _Pragma("unroll") for (int ks = 0; ks < 4; ++ks) { \
                const s16x4 lo_ = vtr(vb + (2 * ks) * (NDB * 512) + (db) * 512 + vlane), h4_ = vtr(vb + (2 * ks + 1) * (NDB * 512) + (db) * 512 + vlane); \
                dst[ks] = (bf16x8){lo_[0], lo_[1], lo_[2], lo_[3], h4_[0], h4_[1], h4_[2], h4_[3]}; } } while (0)
            if (!FIXED) {
            float mx = fmaxf(fmaxf(a0[0], a1[0]), fmaxf(a0[1], a1[1]));
#pragma unroll
            for (int r = 2; r < 16; r += 2) mx = fmaxf(fmaxf(mx, fmaxf(a0[r], a1[r])), fmaxf(a0[r + 1], a1[r + 1]));
            mx = x32_max(mx);
            if (__any(mx > 0.f)) {
                const float dl = fmaxf(mx, 0.f), al = __builtin_amdgcn_exp2f(-dl);
                lrun *= al; mrun += dl;
#pragma unroll
                for (int r = 0; r < 16; ++r) { a0[r] -= dl; a1[r] -= dl; }
#pragma unroll
                for (int db = 0; db < NDB; ++db)
#pragma unroll
                    for (int r = 0; r < 16; ++r) o[db][r] *= al;
            }
            }
            float ls = 0.f;
#pragma unroll
            for (int r = 0; r < 16; ++r) { a0[r] = __builtin_amdgcn_exp2f(a0[r]); a1[r] = __builtin_amdgcn_exp2f(a1[r]); ls += a0[r] + a1[r]; }
            lrun += ls;
            bf16x8 pf[4];
#pragma unroll
            for (int ks = 0; ks < 4; ++ks) { u32x4 p;
#pragma unroll
                for (int e = 0; e < 4; ++e) p[e] = (ks < 2) ? cvt_pk_bf16(a0[8 * ks + 2 * e], a0[8 * ks + 2 * e + 1]) : cvt_pk_bf16(a1[8 * (ks - 2) + 2 * e], a1[8 * (ks - 2) + 2 * e + 1]);
                pf[ks] = __builtin_bit_cast(bf16x8, p); }
#pragma unroll
            for (int db = 0; db < NDB; ++db) {
                ATT_VLOAD(vf, db);
                __builtin_amdgcn_sched_barrier(0);
#pragma unroll
                for (int ks = 0; ks < 4; ++ks) o[db] = MFMA32(vf[ks], pf[ks], o[db]);
                __builtin_amdgcn_sched_barrier(0);
            }
#undef ATT_VLOAD
        }
        if (F32SRC) buf ^= 1;
        else {
        if (j - 2 >= u.jlo) { if (NCH == 2) ATT_WAIT_BAR(4); else ATT_WAIT_BAR(2); }
        else ATT_WAIT_BAR(0);
        buf = (buf == 2) ? 0 : buf + 1;
        }
    }
    if (F32SRC) __syncthreads();
#undef ATT_DMA
#undef ATT_WAIT_BAR
    const float lt = x32_sum(lrun);
    float sc = 1.f / lt;
    if (DIFF) {
        LAS f32x4* xch = (LAS f32x4*)lds;
        if (wact && sub == 1) {
            const float s1 = sc * lam;
#pragma unroll
            for (int db = 0; db < NDB; ++db)
#pragma unroll
                for (int r4 = 0; r4 < 4; ++r4) xch[((qg * NDB + db) * 4 + r4) * 64 + lane] = (f32x4){o[db][4 * r4], o[db][4 * r4 + 1], o[db][4 * r4 + 2], o[db][4 * r4 + 3]} * s1;
        }
        __syncthreads();
        if (wact && sub == 0) {
            float ss = 0.f;
#pragma unroll
            for (int db = 0; db < NDB; ++db)
#pragma unroll
                for (int r4 = 0; r4 < 4; ++r4) { const f32x4 p2 = xch[((qg * NDB + db) * 4 + r4) * 64 + lane];
#pragma unroll
                    for (int i = 0; i < 4; ++i) { const float v = o[db][4 * r4 + i] * sc - p2[i]; o[db][4 * r4 + i] = v; ss += v * v; } }
            ss = x32_sum(ss);
            sc = __builtin_amdgcn_rsqf(ss * (1.f / 128.f) + EPS) * osc;
        }
    }
    if (wact && sub == 0 && qvalid) {
        bf16_t* op = O + (size_t)qrow * PITCH + u.h * HW;
#pragma unroll
        for (int db = 0; db < NDB; ++db)
#pragma unroll
            for (int r4 = 0; r4 < 4; ++r4) {
                const int d = 32 * db + 8 * r4 + 4 * hi;
                f32x4 v = (f32x4){o[db][4 * r4], o[db][4 * r4 + 1], o[db][4 * r4 + 2], o[db][4 * r4 + 3]} * sc;
                if (DIFF) v = v * *(const f32x4*)(subln_g + d);
                u32x2 pk; pk.x = cvt_pk_bf16(v[0], v[1]); pk.y = cvt_pk_bf16(v[2], v[3]);
                *(u32x2*)(op + d) = pk;
            }
    }
    if (DIFF) __syncthreads();
}

__device__ __forceinline__ int prow(int R) { const int nl = R & 255; return (R & ~255) + 128 * ((nl >> 5) & 1) + 32 * (nl >> 6) + (nl & 31); }
__device__ __forceinline__ void transpose_item(const float* W, int K, int N, bf16_t* WT, int row_off, LAS float* scr, int item, int lane) {
    const int nblk = N / 32, kb = item / nblk, nb = item % nblk, k0 = 64 * kb, n0 = 32 * nb;
#pragma unroll 8
    for (int i = 0; i < 32; ++i) { const int kk = 2 * i + (lane >> 5); scr[kk * 33 + (lane & 31)] = W[(size_t)(k0 + kk) * N + n0 + (lane & 31)]; }
    asm volatile("s_waitcnt lgkmcnt(0)" ::: "memory");
    const int c = lane & 7;
#pragma unroll
    for (int j = 0; j < 4; ++j) { const int n = (lane >> 3) + 8 * j; const LAS float* s = scr + (8 * c) * 33 + n;
        u32x4 o; o.x = pk2(s[0 * 33], s[1 * 33]); o.y = pk2(s[2 * 33], s[3 * 33]); o.z = pk2(s[4 * 33], s[5 * 33]); o.w = pk2(s[6 * 33], s[7 * 33]);
        *(u32x4*)(WT + (size_t)prow(row_off + n0 + n) * K + k0 + 8 * c) = o; }
    asm volatile("s_waitcnt lgkmcnt(0)" ::: "memory");
}
__device__ __forceinline__ void rms_row(const float* xrow, const float* g, bf16_t* orow, int lane) {
    const f32x4* xr = (const f32x4*)xrow + lane; f32x4 v[4]; float s = 0.f;
#pragma unroll
    for (int j = 0; j < 4; ++j) { v[j] = xr[64 * j]; s += (v[j].x * v[j].x + v[j].y * v[j].y) + (v[j].z * v[j].z + v[j].w * v[j].w); }
    const float rs = __builtin_amdgcn_rsqf(wave_sum(s) * (1.f / 1024.f) + EPS);
    u32x2* o8 = (u32x2*)orow + lane;
#pragma unroll
    for (int j = 0; j < 4; ++j) { const f32x4 gg = ((const f32x4*)g)[64 * j + lane]; const f32x4 t = v[j] * rs * gg; u32x2 p; p.x = pk2(t.x, t.y); p.y = pk2(t.z, t.w); o8[64 * j] = p; }
}
__device__ __forceinline__ void rms_row2(const float* xa, const float* xb, const float* g, bf16_t* oa, bf16_t* ob, int lane) {
    const f32x4* pa = (const f32x4*)xa + lane; const f32x4* pb = (const f32x4*)xb + lane; f32x4 va[4], vb[4]; float sa = 0.f, sb = 0.f;
#pragma unroll
    for (int j = 0; j < 4; ++j) { va[j] = pa[64 * j]; vb[j] = pb[64 * j]; }
#pragma unroll
    for (int j = 0; j < 4; ++j) { sa += (va[j].x * va[j].x + va[j].y * va[j].y) + (va[j].z * va[j].z + va[j].w * va[j].w); sb += (vb[j].x * vb[j].x + vb[j].y * vb[j].y) + (vb[j].z * vb[j].z + vb[j].w * vb[j].w); }
    const float ra = __builtin_amdgcn_rsqf(wave_sum(sa) * (1.f / 1024.f) + EPS), rb = __builtin_amdgcn_rsqf(wave_sum(sb) * (1.f / 1024.f) + EPS);
    u32x2* qa = (u32x2*)oa + lane; u32x2* qb = (u32x2*)ob + lane;
#pragma unroll
    for (int j = 0; j < 4; ++j) { const f32x4 gg = ((const f32x4*)g)[64 * j + lane]; const f32x4 ta = va[j] * ra * gg, tb = vb[j] * rb * gg;
        u32x2 p; p.x = pk2(ta.x, ta.y); p.y = pk2(ta.z, ta.w); qa[64 * j] = p; u32x2 q; q.x = pk2(tb.x, tb.y); q.y = pk2(tb.z, tb.w); qb[64 * j] = q; }
}
__device__ __forceinline__ void cvt_row(const float* src, bf16_t* dst, int n4, int lane) {
    u32x2* o8 = (u32x2*)dst + lane;
    for (int j = 0; j < n4; ++j) { u32x2 p; p.x = 0u; p.y = 0u; if (src) { const f32x4 t = ((const f32x4*)src)[64 * j + lane]; p.x = pk2(t.x, t.y); p.y = pk2(t.z, t.w); } o8[64 * j] = p; }
}


__device__ __forceinline__ void skinny_splitk(const bf16_t* A, const bf16_t* Wt, const int K, float* C, const int item) {
    int tid = threadIdx.x; asm volatile("" : "+v"(tid));
    const int lane = tid & 63, w = __builtin_amdgcn_readfirstlane(tid >> 6), q32 = lane & 31, hi = lane >> 5;
    const int cblk = item & 31, ksl = item >> 5, klen = K >> 3, k0 = ksl * klen, col = 32 * cblk + q32;
    const bf16_t* ap = A + (size_t)(32 * w + q32) * K + k0 + 8 * hi;
    const bf16_t* bp = Wt + (size_t)prow(col) * K + k0 + 8 * hi;
    f32x16 acc = f32x16{};
#pragma unroll 8
    for (int kk = 0; kk < klen; kk += 16) acc = MFMA32(*(const bf16x8*)(ap + kk), *(const bf16x8*)(bp + kk), acc);
    float* cp = C + (size_t)(32 * w + 4 * hi) * 1024 + col;
#pragma unroll
    for (int r = 0; r < 16; ++r) unsafeAtomicAdd(cp + (size_t)((r & 3) + 8 * (r >> 2)) * 1024, acc[r]);
}
__device__ __forceinline__ void copy_row(const float* src, float* dst, int lane) {
#pragma unroll
    for (int j = 0; j < 4; ++j) ((f32x4*)dst)[64 * j + lane] = ((const f32x4*)src)[64 * j + lane];
}

#define GSYNC() grid.sync()
#define BW_XCNT(j) (1024 + 64 * (j))
#define BW_XSUB(j) (2048 + 64 * (j))
#define BW_XGEN(j) (3072 + 64 * (j))
#define BW_TOP 4096
#define BW_TOPGEN 4160
#define BW_LD(i) __hip_atomic_load(barw + (i), __ATOMIC_RELAXED, __HIP_MEMORY_SCOPE_AGENT)
#define FSYNC() do { asm volatile("s_waitcnt vmcnt(0) lgkmcnt(0)" ::: "memory"); __syncthreads(); ++bar_epoch; \
    if (TIDX == 0) { const unsigned nloc_ = bst[0], nx_ = bst[1], xc_ = bst[2]; \
        const unsigned old_ = __hip_atomic_fetch_add(barw + BW_XSUB(xc_), 1u, __ATOMIC_RELAXED, __HIP_MEMORY_SCOPE_AGENT); \
        if (old_ + 1u == bar_epoch * nloc_) { \
            __builtin_amdgcn_fence(__ATOMIC_RELEASE, "agent"); asm volatile("s_waitcnt vmcnt(0)" ::: "memory"); \
            const unsigned og_ = __hip_atomic_fetch_add(barw + BW_TOP, 1u, __ATOMIC_RELAXED, __HIP_MEMORY_SCOPE_AGENT); \
            if (og_ + 1u == bar_epoch * nx_) __hip_atomic_store(barw + BW_TOPGEN, bar_epoch, __ATOMIC_RELAXED, __HIP_MEMORY_SCOPE_AGENT); \
            else while (BW_LD(BW_TOPGEN) < bar_epoch) { } \
            __builtin_amdgcn_fence(__ATOMIC_ACQUIRE, "agent"); \
            __hip_atomic_store(barw + BW_XGEN(xc_), bar_epoch, __ATOMIC_RELAXED, __HIP_MEMORY_SCOPE_AGENT); asm volatile("s_waitcnt vmcnt(0)" ::: "memory"); \
        } else { while (BW_LD(BW_XGEN(xc_)) < bar_epoch) { } \
            __builtin_amdgcn_fence(__ATOMIC_ACQUIRE, "agent"); asm volatile("s_waitcnt vmcnt(0)" ::: "memory"); } } \
    __syncthreads(); } while (0)

#ifdef NO_ATT2
#define ATT2(...) do{}while(0)
#else
#define ATT2 attn_unit<true, false, false>
#define ATT2F attn_unit<true, true, false>
#define ATT2S attn_unit<true, false, true>
#endif
#ifdef NO_ATT1
#define ATT1(...) do{}while(0)
#else
#define ATT1 attn_unit<false, false, false>
#define ATT1S attn_unit<false, false, true>
#endif

struct Args { const float* in[25]; float* out; unsigned char* ws; };
enum { I_XP = 0, I_XS, I_CAK, I_CAV, I_CBK, I_CBV, I_N1G, I_WIN, I_QNA, I_KNA, I_QNB, I_KNB, I_LQ1, I_LK1, I_LQ2, I_LK2, I_SUBG, I_RELB, I_WBRA, I_WBRB, I_WGATE, I_WOUT, I_N2G, I_WFF1, I_WFF2 };

__global__ void __launch_bounds__(512, 2) fwd_kernel(Args a) {
    extern __shared__ __attribute__((aligned(16))) unsigned char lds_raw[];
    LAS unsigned char* lds = (LAS unsigned char*)lds_raw;
    cg::grid_group grid = cg::this_grid();
    const int wave = __builtin_amdgcn_readfirstlane((int)threadIdx.x >> 6);
    const int G = gridDim.x, bx = blockIdx.x;
#define TIDX ((int)threadIdx.x)
#define LANEX ((int)threadIdx.x & 63)
    const int vcu = (G % 8 == 0) ? (bx % 8) * (G / 8) + bx / 8 : bx;
    const int gw = bx * 8 + wave, NGW = G * 8;
    unsigned char* ws = a.ws; float* out = a.out;
    bf16_t* XN = (bf16_t*)(ws + WS_XN); float* X1 = (float*)(ws + WS_X1);
    bf16_t* QA = (bf16_t*)(ws + WS_QA); bf16_t* QB = (bf16_t*)(ws + WS_QB);
    bf16_t* KA = (bf16_t*)(ws + WS_KA); bf16_t* VA = (bf16_t*)(ws + WS_VA); bf16_t* KB = (bf16_t*)(ws + WS_KB); bf16_t* VB = (bf16_t*)(ws + WS_VB);
    bf16_t* GATE = (bf16_t*)(ws + WS_GATE); bf16_t* UB = (bf16_t*)(ws + WS_U);
    unsigned* barw = (unsigned*)(ws + WS_CTR); unsigned bar_epoch = 0;
    volatile LAS unsigned* bst = (volatile LAS unsigned*)(lds + 143 * 1024);
    if (TIDX == 0) { const unsigned xc = (unsigned)__builtin_amdgcn_s_getreg((3 << 11) | 20) & 0xFu; bst[2] = xc; __hip_atomic_fetch_add(barw + BW_XCNT(xc), 1u, __ATOMIC_RELAXED, __HIP_MEMORY_SCOPE_AGENT); }
    float* Y = out + O_Y;

    if (bx == 0 && TIDX < 64) ((unsigned*)(ws + WS_CTR))[TIDX] = 0u;
    {
        LAS float* scr = (LAS float*)(lds + wave * 16384);
        int ln0 = LANEX; asm volatile("" : "+v"(ln0));
        constexpr int I_IN = 16 * 144, I_GT = 16 * 64, I_A = 16 * 32, I_B = 8 * 32, I_O = 16 * 32, I_1 = 16 * 128, I_2 = 64 * 32, I_L = I_IN + I_GT + I_A + I_B + I_O + I_1 + I_2;
        for (int it = gw; it < 2 * I_L; it += NGW) {
            const int l = it / I_L; int r = it % I_L; unsigned char* wl = ws + WS_W + (size_t)l * WL_SIZE;
            if (r < I_IN) { transpose_item(a.in[I_WIN] + (size_t)l * 1024 * NIN, 1024, NIN, (bf16_t*)(wl + WL_W1), 0, scr, r, ln0); continue; } r -= I_IN;
            if (r < I_GT) { transpose_item(a.in[I_WGATE] + (size_t)l * 1024 * 2048, 1024, 2048, (bf16_t*)(wl + WL_W1), NIN, scr, r, ln0); continue; } r -= I_GT;
            if (r < I_A)  { transpose_item(a.in[I_WBRA] + (size_t)l * 1024 * 1024, 1024, 1024, (bf16_t*)(wl + WL_BRA), 0, scr, r, ln0); continue; } r -= I_A;
            if (r < I_B)  { transpose_item(a.in[I_WBRB] + (size_t)l * 512 * 1024, 512, 1024, (bf16_t*)(wl + WL_BRB), 0, scr, r, ln0); continue; } r -= I_B;
            if (r < I_O)  { transpose_item(a.in[I_WOUT] + (size_t)l * 1024 * 1024, 1024, 1024, (bf16_t*)(wl + WL_OUT), 0, scr, r, ln0); continue; } r -= I_O;
            if (r < I_1)  { transpose_item(a.in[I_WFF1] + (size_t)l * 1024 * DFF, 1024, DFF, (bf16_t*)(wl + WL_FF1), 0, scr, r, ln0); continue; } r -= I_1;
            transpose_item(a.in[I_WFF2] + (size_t)l * DFF * 1024, DFF, 1024, (bf16_t*)(wl + WL_FF2), 0, scr, r, ln0);
        }
    }

    for (int l = 0; l < 2; ++l) {
        int gwo = gw; asm volatile("" : "+s"(gwo));
        int ln = LANEX; asm volatile("" : "+v"(ln));
        for (int m = gwo; m < MT; m += 2 * NGW) {
            const int m2 = (m + NGW < MT) ? m + NGW : m;
            const float* xa = (l == 0) ? (m < MP ? a.in[I_XP] + (size_t)m * 1024 : a.in[I_XS] + (size_t)(m - MP) * 1024) : Y + (size_t)m * 1024;
            const float* xb = (l == 0) ? (m2 < MP ? a.in[I_XP] + (size_t)m2 * 1024 : a.in[I_XS] + (size_t)(m2 - MP) * 1024) : Y + (size_t)m2 * 1024;
            rms_row2(xa, xb, a.in[I_N1G] + l * 1024, XN + (size_t)m * 1024, XN + (size_t)m2 * 1024, ln);
        }
        for (int m = gwo; m < MS; m += NGW) copy_row((l == 0) ? a.in[I_XS] + (size_t)m * 1024 : Y + (size_t)(MP + m) * 1024, X1 + (size_t)(MP + m) * 1024, ln);
        if (l == 0) { GSYNC();
            if (TIDX == 0) { unsigned mine = 0u, cnt = 0u; const unsigned xc = bst[2];
                for (unsigned jx = 0; jx < 16; ++jx) { const unsigned c = BW_LD(BW_XCNT(jx)); cnt += (c > 0u) ? 1u : 0u; mine = (jx == xc) ? c : mine; }
                bst[0] = mine; bst[1] = cnt; } }
        else FSYNC();

        unsigned char* wl = ws + WS_W + (size_t)l * WL_SIZE;
        {
            pg8::Gemm g{XN, (const bf16_t*)(wl + WL_W1), MT, NG1, 1024}; pg8::StaticOrder S; S.init(MT, NG1, G, bx);
            EpiG1 E{QA, KA, VA, QB, KB, VB, GATE, out, l, a.in[I_QNA] + l * 64, a.in[I_KNA] + l * 64, a.in[I_QNB] + l * 64, a.in[I_KNB] + l * 64};
            pg8::gemm_phase<EpiG1, pg8::StaticOrder, true, true>(lds, g, S, E);
        }
        FSYNC();

        {
            float lam;
            { int la = LANEX; asm volatile("" : "+v"(la)); const float p1 = wave_sum(a.in[I_LQ1][l * 64 + la] * a.in[I_LK1][l * 64 + la]), p2 = wave_sum(a.in[I_LQ2][l * 64 + la] * a.in[I_LK2][l * 64 + la]);
              const float lam_init = 0.8f - 0.6f * __expf(-0.3f * (float)l); lam = __expf(p1) - __expf(p2) + lam_init; }
            const float osc = 1.f - (0.8f - 0.6f * __expf(-0.3f * (float)l));
            const float* subg = a.in[I_SUBG] + l * 128;
            LAS float* tab = (LAS float*)(lds + 140 * 1024);
            int tda = TIDX; asm volatile("" : "+v"(tda));
            const float* relb = a.in[I_RELB] + (size_t)l * 8 * 257;
            float smax;
            { int la = LANEX; asm volatile("" : "+v"(la)); smax = 8.08f * wave_max(__builtin_fabsf(a.in[I_QNA][l * 64 + la])) * wave_max(__builtin_fabsf(a.in[I_KNA][l * 64 + la])); }
            smax = __builtin_bit_cast(float, __builtin_amdgcn_readfirstlane(__builtin_bit_cast(int, smax)));
            lam = __builtin_bit_cast(float, __builtin_amdgcn_readfirstlane(__builtin_bit_cast(int, lam)));
            const float mref0 = -smax * LOG2E;
            unsigned* ctr = (unsigned*)(ws + WS_CTR) + l * 16;
            LAS int* nxt = (LAS int*)(lds + 142 * 1024);
            int qx = (int)(__builtin_amdgcn_s_getreg((3 << 11) | 20) & 7u), tried = 0;
#define QND(x) ((((x) & 3) == 0) ? 192 : ((((x) & 3) == 1) ? 320 : ((((x) & 3) == 2) ? 128 : 384)))
            for (;;) {
                __syncthreads();
                if (tda == 0) {
                    int v;
                    for (;;) { v = (int)atomicAdd(ctr + qx, 1u); if (v < 32 + QND(qx) + 128 || tried == 7) break; qx = (qx + 1) & 7; ++tried; }
                    nxt[0] = v; nxt[1] = qx;
                }
                __syncthreads();
                int idx = nxt[0]; const int x = nxt[1];
                if (idx >= 32 + QND(x) + 128) break;
                {
                    const int n1 = ((x & 3) < 2) ? 32 : (((x & 3) == 2) ? 100 : 128);
                    if (idx < n1) idx += 32; else if (idx < n1 + 32) idx -= n1;
                }
                if (idx < 16) {
                    const int id = x * 16 + idx, sq = id >> 3, h = id & 7;
                    AUnit u{MP + 16 * sq, MP + sq * SA_LEN, 2048, 16, 2064, h, 0, 32};
                    ATT2S(lds, QA, KA, VA, QA, u, a.in[I_CAK] + (size_t)(l * 16 + sq) * 2048 * 1024, a.in[I_CAV] + (size_t)(l * 16 + sq) * 2048 * 1024, out + O_AK_S + (size_t)l * 262144 + (size_t)sq * 16 * 1024, out + O_AV_S + (size_t)l * 262144 + (size_t)sq * 16 * 1024,
                          1 << 20, exp2f(-(float)(h + 1)) * LOG2E, lam, subg, osc, tab, mref0);
                } else if (idx < 32) {
                    const int id = x * 16 + idx - 16, sq = id >> 3, h = id & 7;
                    if (tda < 257) tab[tda] = relb[h * 257 + tda] * LOG2E;
                    AUnit u{MP + 16 * sq, MP + sq * SB_LEN, 512, 16, 528, h, 0, 8};
                    ATT1S(lds, QB, KB, VB, QB, u, a.in[I_CBK] + (size_t)(l * 16 + sq) * 512 * 512, a.in[I_CBV] + (size_t)(l * 16 + sq) * 512 * 512, out + O_BK_S + (size_t)l * 131072 + (size_t)sq * 16 * 512, out + O_BV_S + (size_t)l * 131072 + (size_t)sq * 16 * 512,
                          8, 0.f, 0.f, nullptr, 1.f, tab, mref0);
                } else if (idx < 32 + QND(x)) {
                    idx -= 32; const int b = x >> 2, t = x & 3; int h, qb;
                    if (t == 0)      { if (idx < 64) { h = 7; qb = 127 - 2 * idx; } else { h = 3; qb = 127 - (idx - 64); } }
                    else if (t == 1) { if (idx < 64) { h = 7; qb = 126 - 2 * idx; } else if (idx < 192) { h = 2; qb = 127 - (idx - 64); } else { h = 0; qb = 127 - (idx - 192); } }
                    else if (t == 2) { h = 6; qb = 127 - idx; }
                    else             { const int which = idx >> 7; h = (which == 0) ? 5 : ((which == 1) ? 4 : 1); qb = 127 - (idx & 127); }
                    const float slope = exp2f(-(float)(h + 1));
                    const float dmax = (2.f * smax + 17.33f - __logf(1.f - __expf(-slope))) / slope;
                    const int win = (dmax > 1.0e6f) ? (1 << 20) : (int)((dmax + 63.f) * (1.f / 64.f)) + 1;
                    AUnit u{b * SEQ + 128 * qb, b * SEQ, 128 * qb, 128, 1 << 30, h, max(0, 2 * qb - win), 2 * qb + 1};
                    if (smax * LOG2E < 40.f) ATT2F(lds, QA, KA, VA, QA, u, nullptr, nullptr, nullptr, nullptr, win, slope * LOG2E, lam, subg, osc, tab, smax * LOG2E);
                    else ATT2(lds, QA, KA, VA, QA, u, nullptr, nullptr, nullptr, nullptr, win, slope * LOG2E, lam, subg, osc, tab, mref0);
                } else {
                    idx -= 32 + QND(x); const int id = x * 128 + idx, bh = id >> 6, qb = id & 63, b = bh >> 3, h = bh & 7;
                    if (tda < 257) tab[tda] = relb[h * 257 + tda] * LOG2E;
                    const int c0 = 4 * qb;
                    AUnit u{b * SEQ + 256 * qb, b * SEQ, 256 * qb, 256, 1 << 30, h, max(0, c0 - 8), c0 + 3};
                    ATT1(lds, QB, KB, VB, QB, u, nullptr, nullptr, nullptr, nullptr, 8, 0.f, 0.f, nullptr, 1.f, tab, mref0);
                }
            }
#undef QND
        }
        FSYNC();

        {
            pg8::Gemm g{QB, (const bf16_t*)(wl + WL_BRB), MT, 1024, 512}; pg8::StaticOrder S; S.init(MT, 1024, G, bx);
            EpiGate<false> E{XN, GATE + 1024};
            pg8::gemm_phase<EpiGate<false>, pg8::StaticOrder, true, true>(lds, g, S, E);
        }
        {
            pg8::Gemm g{QA, (const bf16_t*)(wl + WL_BRA), MT, 1024, 1024}; pg8::StaticOrder S; S.init(MT, 1024, G, bx);
            EpiGate<true> E{XN, GATE};
            pg8::gemm_phase<EpiGate<true>, pg8::StaticOrder, true, true>(lds, g, S, E);
        }
        FSYNC();
        {
            pg8::Gemm g{XN, (const bf16_t*)(wl + WL_OUT), MP, 1024, 1024}; pg8::StaticOrder S; S.init(MP, 1024, G, bx);
            EpiResid E{(l == 0) ? a.in[I_XP] : Y, (l == 0) ? a.in[I_XS] : Y + (size_t)MP * 1024, X1};
            pg8::gemm_phase<EpiResid, pg8::StaticOrder, true, true>(lds, g, S, E);
            int bxo = bx; asm volatile("" : "+s"(bxo));
            for (int it = bxo; it < 256; it += G) skinny_splitk(XN + (size_t)MP * 1024, (const bf16_t*)(wl + WL_OUT), 1024, X1 + (size_t)MP * 1024, it);
        }
        FSYNC();
        { int ln2 = LANEX; asm volatile("" : "+v"(ln2));
          int gwo2 = gw; asm volatile("" : "+s"(gwo2));
          for (int m = gwo2; m < MT; m += 2 * NGW) { const int m2 = (m + NGW < MT) ? m + NGW : m;
              rms_row2(X1 + (size_t)m * 1024, X1 + (size_t)m2 * 1024, a.in[I_N2G] + l * 1024, XN + (size_t)m * 1024, XN + (size_t)m2 * 1024, ln2); }
          for (int m = gwo2; m < MS; m += NGW) copy_row(X1 + (size_t)(MP + m) * 1024, Y + (size_t)(MP + m) * 1024, ln2); }
        FSYNC();
        {
            pg8::Gemm g{XN, (const bf16_t*)(wl + WL_FF1), MT, DFF, 1024}; pg8::StaticOrder S; S.init(MT, DFF, G, bx);
            EpiRelu2 E{UB};
            pg8::gemm_phase<EpiRelu2, pg8::StaticOrder, true, true>(lds, g, S, E);
        }
        FSYNC();
        {
            pg8::Gemm g{UB, (const bf16_t*)(wl + WL_FF2), MP, 1024, DFF}; pg8::StaticOrder S; S.init(MP, 1024, G, bx);
            EpiResid E{X1, X1 + (size_t)MP * 1024, Y};
            pg8::gemm_phase<EpiResid, pg8::StaticOrder, true, true>(lds, g, S, E);
            int bxo = bx; asm volatile("" : "+s"(bxo));
            for (int it = bxo; it < 256; it += G) skinny_splitk(UB + (size_t)MP * DFF, (const bf16_t*)(wl + WL_FF2), DFF, Y + (size_t)MP * 1024, it);
        }
        if (l == 0) FSYNC();
    }
}

extern "C" void kernel_launch(void* const* d_in, const int* in_sizes, int n_in, void* d_out, int out_size, void* d_ws, size_t ws_size, hipStream_t stream) {
    static int grid = 0;
    if (grid == 0) {
        if (n_in != 25 || ws_size < WS_END + 32768) { fprintf(stderr, "kernel_launch: unexpected n_in %d / ws %zu\n", n_in, ws_size); grid = -1; return; }
        int dev = 0, cus = 0, per_cu = 0;
        hipGetDevice(&dev); hipDeviceGetAttribute(&cus, hipDeviceAttributeMultiprocessorCount, dev);
        if (hipFuncSetAttribute((const void*)fwd_kernel, hipFuncAttributeMaxDynamicSharedMemorySize, LDS_BYTES) != hipSuccess) { fprintf(stderr, "kernel_launch: hipFuncSetAttribute failed\n"); }
        if (hipOccupancyMaxActiveBlocksPerMultiprocessor(&per_cu, (const void*)fwd_kernel, 512, LDS_BYTES) != hipSuccess || per_cu < 1) { fprintf(stderr, "kernel_launch: occupancy query says %d\n", per_cu); per_cu = 1; }
        (void)hipGetLastError();
        grid = cus * 1;
    }
    if (grid < 0) return;
    if (hipMemsetAsync((char*)d_ws + WS_CTR, 0, 32768, stream) != hipSuccess) { fprintf(stderr, "kernel_launch: memset of the control words failed\n"); return; }
    Args a{};
    for (int i = 0; i < 25; ++i) a.in[i] = (const float*)d_in[i];
    a.out = (float*)d_out; a.ws = (unsigned char*)d_ws;
    void* args[] = {&a};
    hipError_t e = hipLaunchCooperativeKernel((const void*)fwd_kernel, dim3(grid), dim3(512), args, LDS_BYTES, stream);
    if (e != hipSuccess) fprintf(stderr, "cooperative launch failed: %s (grid %d)\n", hipGetErrorString(e), grid);
}
```
